# Optimizing an MI355X kernel written in HIP

```python
import math
import jax, jax.numpy as jnp
from jax import lax
import numpy as np

D_MODEL = 1024
BATCH = 32
SEQ = 2048
DEPTH = 1

CTX_LEN = 256
GRID_W = 64
SSM_WIDTH = 512
SSM_GROUP = 16
SSM_GROUPS = SSM_WIDTH // SSM_GROUP
SSM_STATE = 64
DT_MIN = 1e-3
DT_MAX = 1e-1
SSM_C_STD = 0.5
SCONV_WIDTH = 512
SCONV_K = 3
FFN_HIDDEN = 2816
FFN_K = 3
N_BRANCH = 2
PROJ_COLS = SSM_WIDTH + 3 * SCONV_WIDTH + N_BRANCH * D_MODEL
N_MOD = 6
EPS = 1e-6

kernel_name = 'hybrid_s5_shortconv_convffn_prefix_block'


def rmsnorm(x, g):
    xf = x.astype(jnp.float32)
    r = lax.rsqrt(jnp.mean(xf * xf, axis=-1, keepdims=True) + EPS)
    return (xf * r).astype(x.dtype) * g


def modulate(h, shift, scale):
    return h * (1 + scale) + shift


def adaln(cond, w, b):
    m = jax.nn.silu(cond) @ w + b
    return jnp.split(m, N_MOD, axis=-1)


def s5_discretise(lam_re, lam_im, log_dt, b_re, b_im):
    lam = lax.complex(lam_re.astype(jnp.float32), lam_im.astype(jnp.float32))
    dt = jnp.exp(log_dt.astype(jnp.float32))[:, None]
    a_bar = jnp.exp(lam * dt)
    b = lax.complex(b_re.astype(jnp.float32), b_im.astype(jnp.float32))
    b_bar = ((a_bar - 1) / lam)[..., None] * b
    return a_bar, b_bar


def _lin_rec_combine(e1, e2):
    a1, b1 = e1
    a2, b2 = e2
    return a1 * a2, a2 * b1 + b2


def s5_states(u, a_bar, b_bar, init, reverse):
    uf = u.astype(jnp.float32)
    if reverse:
        uf = uf[:, ::-1]
    bu = jnp.einsum('blgh,gph->lbgp', uf.astype(jnp.complex64), b_bar)
    if init is not None:
        bu = bu.at[0].add(a_bar * init)
    a = jnp.broadcast_to(a_bar, (bu.shape[0], 1) + a_bar.shape)
    _, states = lax.associative_scan(_lin_rec_combine, (a, bu), axis=0)
    return states


def s5_readout(states, c_re, c_im, reverse):
    c = lax.complex(c_re.astype(jnp.float32), c_im.astype(jnp.float32))
    y = jnp.real(jnp.einsum('lbgp,ghp->blgh', states, c))
    return y[:, ::-1] if reverse else y


def s5_glu(y, w, b):
    z = jax.nn.gelu(y)
    return z * jax.nn.sigmoid(z @ w + b)


def s5_branch(u_lat, u_ctx, lam_re, lam_im, log_dt, b_re, b_im, c_re, c_im, d_skip, glu_w, glu_b, ctx_out):
    bsz, seq, _ = u_lat.shape
    ctx_len = u_ctx.shape[1]
    ul = u_lat.reshape(bsz, seq, SSM_GROUPS, SSM_GROUP)
    uc = u_ctx.reshape(bsz, ctx_len, SSM_GROUPS, SSM_GROUP)
    y_lat = d_skip * u_lat.astype(jnp.float32)
    y_ctx = d_skip * u_ctx.astype(jnp.float32) if ctx_out else None
    for direction in range(2):
        rev = direction == 1
        a_bar, b_bar = s5_discretise(lam_re[direction], lam_im[direction], log_dt[direction],
                                     b_re[direction], b_im[direction])
        s_ctx = s5_states(uc, a_bar, b_bar, None, rev)
        s_lat = s5_states(ul, a_bar, b_bar, s_ctx[-1], rev)
        y_lat = y_lat + s5_readout(s_lat, c_re[direction], c_im[direction], rev).reshape(bsz, seq, SSM_WIDTH)
        if ctx_out:
            y_ctx = y_ctx + s5_readout(s_ctx, c_re[direction], c_im[direction], rev).reshape(bsz, ctx_len, SSM_WIDTH)
    y_lat = s5_glu(y_lat, glu_w, glu_b).astype(u_lat.dtype)
    if ctx_out:
        y_ctx = s5_glu(y_ctx, glu_w, glu_b).astype(u_ctx.dtype)
    return y_lat, y_ctx


def depthwise_conv1d(x, w):
    return lax.conv_general_dilated(x, w[:, None, :], window_strides=(1,), padding='SAME',
                                    dimension_numbers=('NWC', 'WIO', 'NWC'),
                                    feature_group_count=x.shape[-1])


def depthwise_conv2d(x, w, rows, cols):
    bsz, seq, ch = x.shape
    y = lax.conv_general_dilated(x.reshape(bsz, rows, cols, ch), w[:, :, None, :],
                                 window_strides=(1, 1), padding='SAME',
                                 dimension_numbers=('NHWC', 'HWIO', 'NHWC'),
                                 feature_group_count=ch)
    return y.reshape(bsz, seq, ch)


def mixer_merge(p, y_a, sconv_w, proj_a, proj_b, w_out):
    o = SSM_WIDTH
    w = SCONV_WIDTH
    b_gate = p[..., o:o + w]
    c_gate = p[..., o + w:o + 2 * w]
    x_val = p[..., o + 2 * w:o + 3 * w]
    o2 = o + 3 * w
    gate_a = jax.nn.sigmoid(p[..., o2:o2 + D_MODEL])
    gate_b = jax.nn.sigmoid(p[..., o2 + D_MODEL:o2 + 2 * D_MODEL])
    y_b = b_gate * depthwise_conv1d(c_gate * x_val, sconv_w)
    merged = gate_a * (y_a @ proj_a) + gate_b * (y_b @ proj_b)
    return merged @ w_out


def conv_ffn(h, rows, cols, w_up, conv_w, w_down):
    u = depthwise_conv2d(h @ w_up, conv_w, rows, cols)
    a, v = jnp.split(u, 2, axis=-1)
    return (jax.nn.silu(a) * v) @ w_down


def setup_inputs(seed: int = 0) -> dict:
    key = jax.random.key(seed)
    ks = jax.random.split(key, 32)
    f32 = jnp.float32
    G, P, H = SSM_GROUPS, SSM_STATE, SSM_GROUP
    n_idx = jnp.arange(P, dtype=f32)
    lam_re = -0.5 + 0.01 * jax.random.normal(ks[8], (DEPTH, 2, G, P), f32)
    lam_im = math.pi * n_idx + 0.01 * jax.random.normal(ks[9], (DEPTH, 2, G, P), f32)
    log_dt = jax.random.uniform(ks[10], (DEPTH, 2, G), f32, math.log(DT_MIN), math.log(DT_MAX))
    return {
        'x': jax.random.normal(ks[0], (BATCH, SEQ, D_MODEL), f32),
        'c': jax.random.normal(ks[1], (BATCH, D_MODEL), f32),
        'ctx': jax.random.normal(ks[2], (BATCH, CTX_LEN, D_MODEL), f32),
        'c_ctx': jax.random.normal(ks[3], (D_MODEL,), f32),
        'mod_w': jax.random.normal(ks[4], (DEPTH, D_MODEL, N_MOD * D_MODEL), f32) * 0.5 * D_MODEL ** -0.5,
        'mod_b': 0.01 * jax.random.normal(ks[5], (DEPTH, N_MOD * D_MODEL), f32),
        'norm1_g': 1.0 + 0.02 * jax.random.normal(ks[6], (DEPTH, D_MODEL), f32),
        'norm2_g': 1.0 + 0.02 * jax.random.normal(ks[7], (DEPTH, D_MODEL), f32),
        'w_in': jax.random.normal(ks[11], (DEPTH, D_MODEL, PROJ_COLS), f32) * D_MODEL ** -0.5,
        'ssm_lambda_re': lam_re,
        'ssm_lambda_im': lam_im,
        'ssm_log_dt': log_dt,
        'ssm_b_re': jax.random.normal(ks[12], (DEPTH, 2, G, P, H), f32) * (2 * H) ** -0.5,
        'ssm_b_im': jax.random.normal(ks[13], (DEPTH, 2, G, P, H), f32) * (2 * H) ** -0.5,
        'ssm_c_re': jax.random.normal(ks[14], (DEPTH, 2, G, H, P), f32) * SSM_C_STD,
        'ssm_c_im': jax.random.normal(ks[15], (DEPTH, 2, G, H, P), f32) * SSM_C_STD,
        'ssm_d': jax.random.normal(ks[16], (DEPTH, SSM_WIDTH), f32),
        'ssm_glu_w': jax.random.normal(ks[17], (DEPTH, SSM_WIDTH, SSM_WIDTH), f32) * SSM_WIDTH ** -0.5,
        'ssm_glu_b': 0.01 * jax.random.normal(ks[18], (DEPTH, SSM_WIDTH), f32),
        'sconv_w': jax.random.normal(ks[19], (DEPTH, SCONV_K, SCONV_WIDTH), f32) * SCONV_K ** -0.5,
        'proj_a': jax.random.normal(ks[20], (DEPTH, SSM_WIDTH, D_MODEL), f32) * SSM_WIDTH ** -0.5,
        'proj_b': jax.random.normal(ks[21], (DEPTH, SCONV_WIDTH, D_MODEL), f32) * SCONV_WIDTH ** -0.5,
        'w_out': jax.random.normal(ks[22], (DEPTH, D_MODEL, D_MODEL), f32) * D_MODEL ** -0.5,
        'ffn_w_up': jax.random.normal(ks[23], (DEPTH, D_MODEL, 2 * FFN_HIDDEN), f32) * D_MODEL ** -0.5,
        'ffn_conv_w': jax.random.normal(ks[24], (DEPTH, FFN_K, FFN_K, 2 * FFN_HIDDEN), f32) / FFN_K,
        'ffn_w_down': jax.random.normal(ks[25], (DEPTH, FFN_HIDDEN, D_MODEL), f32) * FFN_HIDDEN ** -0.5,
        'final_g': 1.0 + 0.02 * jax.random.normal(ks[26], (D_MODEL,), f32),
    }


def reference(x, c, ctx, c_ctx, mod_w, mod_b, norm1_g, norm2_g, w_in, ssm_lambda_re, ssm_lambda_im,
              ssm_log_dt, ssm_b_re, ssm_b_im, ssm_c_re, ssm_c_im, ssm_d, ssm_glu_w, ssm_glu_b,
              sconv_w, proj_a, proj_b, w_out, ffn_w_up, ffn_conv_w, ffn_w_down, final_g):
    rows = x.shape[1] // GRID_W
    ctx_len = ctx.shape[1]
    for i in range(DEPTH):
        last = i == DEPTH - 1
        sh1, sc1, g1, sh2, sc2, g2 = adaln(c[:, None, :], mod_w[i], mod_b[i])
        csh1, csc1, cg1, csh2, csc2, cg2 = adaln(c_ctx[None, None, :], mod_w[i], mod_b[i])

        h = modulate(rmsnorm(x, norm1_g[i]), sh1, sc1)
        hc = modulate(rmsnorm(ctx, norm1_g[i]), csh1, csc1)
        p = h @ w_in[i]
        pc = hc @ (w_in[i][:, :SSM_WIDTH] if last else w_in[i])
        y_a, y_a_ctx = s5_branch(p[..., :SSM_WIDTH], pc[..., :SSM_WIDTH],
                                 ssm_lambda_re[i], ssm_lambda_im[i], ssm_log_dt[i],
                                 ssm_b_re[i], ssm_b_im[i], ssm_c_re[i], ssm_c_im[i],
                                 ssm_d[i], ssm_glu_w[i], ssm_glu_b[i], not last)
        x = x + g1 * mixer_merge(p, y_a, sconv_w[i], proj_a[i], proj_b[i], w_out[i])
        if not last:
            ctx = ctx + cg1 * mixer_merge(pc, y_a_ctx, sconv_w[i], proj_a[i], proj_b[i], w_out[i])

        h2 = modulate(rmsnorm(x, norm2_g[i]), sh2, sc2)
        x = x + g2 * conv_ffn(h2, rows, GRID_W, ffn_w_up[i], ffn_conv_w[i], ffn_w_down[i])
        if not last:
            hc2 = modulate(rmsnorm(ctx, norm2_g[i]), csh2, csc2)
            ctx = ctx + cg2 * conv_ffn(hc2, 1, ctx_len, ffn_w_up[i], ffn_conv_w[i], ffn_w_down[i])
    return rmsnorm(x, final_g)
```

```cpp
#include <hip/hip_runtime.h>
#include <hip/hip_cooperative_groups.h>
#include <stdint.h>
#include <cstdio>
namespace cg = cooperative_groups;

#ifndef MK_ONE_LAUNCH
#define MK_ONE_LAUNCH 1
#endif
#ifndef OPT_MASK
#define OPT_MASK 0xFF
#endif

typedef unsigned short bf16_t;
typedef float f32x4 __attribute__((ext_vector_type(4)));
typedef float f32x2 __attribute__((ext_vector_type(2)));
typedef unsigned u32x4 __attribute__((ext_vector_type(4)));
typedef unsigned u32x2 __attribute__((ext_vector_type(2)));
typedef short bf16x8 __attribute__((ext_vector_type(8)));
#define LAS __attribute__((address_space(3)))

constexpr int D = 1024, NB = 32, SEQ = 2048, CTXL = 256;
constexpr int M = NB * SEQ;
constexpr int MC = NB * CTXL;
constexpr int PCOLS = 4096, SW = 512, NG = 32, GH = 16, PS = 64;
constexpr int FH = 2816, F2 = 5632;
constexpr int TCH = 64;
constexpr int NCL = SEQ / TCH;
constexpr int NCC = CTXL / TCH;
constexpr int AGK = TCH * GH + 4 * PS;
constexpr int AGR = NB * NCL + NB * NCC;
constexpr int PW = PCOLS - SW;
constexpr int HALF_ROWS = M / 2;
constexpr float EPS = 1e-6f;

constexpr size_t MiB = 1ull << 20;
constexpr size_t WS_CTL = 0;
constexpr size_t WS_MOD = 64 * 1024;
constexpr size_t WS_BIASUP = 1 * MiB;
constexpr size_t WS_SS1 = 2 * MiB;
constexpr size_t WS_SS2 = 2 * MiB + 256 * 1024;
constexpr size_t CTL_ZERO_BYTES = 3 * MiB;
constexpr size_t WS_WIN = 4 * MiB;
constexpr size_t WS_WGLU = 12 * MiB;
constexpr size_t WS_WPA = 13 * MiB;
constexpr size_t WS_WPB = 14 * MiB;
constexpr size_t WS_WOUT = 15 * MiB;
constexpr size_t WS_WUP = 17 * MiB;
constexpr size_t WS_WDOWN = 28 * MiB;
constexpr size_t WS_OP = 34 * MiB;
constexpr size_t WS_WE = 114 * MiB;
constexpr size_t WS_P = 130 * MiB;
constexpr size_t WS_H = 578 * MiB;
constexpr size_t WS_AG = 722 * MiB;
constexpr size_t WS_E = 812 * MiB;
constexpr size_t WS_YBR = 850 * MiB;
constexpr size_t WS_Z = 914 * MiB;
constexpr size_t WS_YA = 578 * MiB;
constexpr size_t WS_MERGED = 722 * MiB;
constexpr size_t WS_X1S = 130 * MiB;
constexpr size_t WS_UP = 258 * MiB;
constexpr size_t WS_ACT = 610 * MiB;
constexpr size_t WS_KT = 1016 * MiB;
constexpr size_t WS_APW = 1020 * MiB;
constexpr size_t WS_NEED = 1024 * MiB;

__device__ __forceinline__ float bf2f(bf16_t v) { return __uint_as_float(((unsigned)v) << 16); }
__device__ __forceinline__ bf16_t f2bf(float f) { unsigned u = __float_as_uint(f); return (bf16_t)((u + 0x7fffu + ((u >> 16) & 1u)) >> 16); }
__device__ __forceinline__ float sigmoidf_(float x) { return 1.f / (1.f + __expf(-x)); }
__device__ __forceinline__ float siluf_(float x) { return x * sigmoidf_(x); }
__device__ __forceinline__ float gelu_tanh(float x) { const float k = 0.7978845608028654f; return 0.5f * x * (1.f + tanhf(k * (x + 0.044715f * x * x * x))); }
__device__ __forceinline__ float wave_sum(float v) {
#pragma unroll
    for (int o = 1; o < 64; o <<= 1) v += __shfl_xor(v, o);
    return v;
}
__device__ __forceinline__ float fsig(float x) { return __builtin_amdgcn_rcpf(1.f + __builtin_amdgcn_exp2f(-1.4426950408889634f * x)); }
__device__ __forceinline__ float fgelu(float x) { const float y = 1.5957691216057308f * (x + 0.044715f * x * x * x); return x * fsig(y); }
__device__ __forceinline__ unsigned cvt_pk_bf16(float lo, float hi) { unsigned r; asm volatile("v_cvt_pk_bf16_f32 %0, %1, %2" : "=v"(r) : "v"(lo), "v"(hi)); return r; }
__device__ __forceinline__ u32x4 pack8(const f32x4 a, const f32x4 b) { u32x4 w; w.x = cvt_pk_bf16(a[0], a[1]); w.y = cvt_pk_bf16(a[2], a[3]); w.z = cvt_pk_bf16(b[0], b[1]); w.w = cvt_pk_bf16(b[2], b[3]); return w; }
__device__ __forceinline__ void unpack8(const u32x4 w, f32x4& a, f32x4& b) {
    a[0] = __uint_as_float(w.x << 16); a[1] = __uint_as_float(w.x & 0xffff0000u); a[2] = __uint_as_float(w.y << 16); a[3] = __uint_as_float(w.y & 0xffff0000u);
    b[0] = __uint_as_float(w.z << 16); b[1] = __uint_as_float(w.z & 0xffff0000u); b[2] = __uint_as_float(w.w << 16); b[3] = __uint_as_float(w.w & 0xffff0000u); }

__device__ __forceinline__ void ssm_disc(float lr, float li, float dt, float& ar, float& ai, float& qr, float& qi) {
    const float ex = expf(lr * dt); float sn, cs; sincosf(li * dt, &sn, &cs);
    ar = ex * cs; ai = ex * sn;
    float sh, chh; sincosf(0.5f * li * dt, &sh, &chh);
    const float xr = expm1f(lr * dt) * cs - 2.f * sh * sh, xi = ex * sn;
    const float den = lr * lr + li * li;
    qr = (xr * lr + xi * li) / den; qi = (xi * lr - xr * li) / den;
}
__device__ __forceinline__ void ssm_apow(float lr, float li, float dt, float k, float& pr, float& pi) {
    const float ex = expf(lr * dt * k); float sn, cs; sincosf(li * dt * k, &sn, &cs); pr = ex * cs; pi = ex * sn;
}

__global__ void k_mod(const float* c, const float* c_ctx, const float* mod_w, const float* mod_b, float* MOD) {
    int n = blockIdx.x * blockDim.x + threadIdx.x; int r = blockIdx.y;
    if (n >= 6 * D) return;
    const float* cond = r < NB ? c + (size_t)r * D : c_ctx;
    float acc = 0.f;
    for (int k = 0; k < D; ++k) acc += siluf_(cond[k]) * mod_w[(size_t)k * 6 * D + n];
    MOD[(size_t)r * 6 * D + n] = acc + mod_b[n];
}
__global__ void k_norm1(const float* x, const float* ctx, const float* g, const float* MOD, bf16_t* H) {
    int row = blockIdx.x * (blockDim.x / 64) + (threadIdx.x >> 6); int lane = threadIdx.x & 63;
    if (row >= M + MC) return;
    const float* xr; int mr;
    if (row < M) { xr = x + (size_t)row * D; mr = row / SEQ; } else { xr = ctx + (size_t)(row - M) * D; mr = NB; }
    const float* sh = MOD + (size_t)mr * 6 * D; const float* sc = sh + D;
    float ss = 0.f;
    for (int k = lane; k < D; k += 64) { float v = xr[k]; ss += v * v; }
    ss = wave_sum(ss);
    float r = rsqrtf(ss / D + EPS);
    for (int k = lane; k < D; k += 64) H[(size_t)row * D + k] = f2bf(xr[k] * r * g[k] * (1.f + sc[k]) + sh[k]);
}
template <class Epi>
__global__ void __launch_bounds__(256) k_gemm(const bf16_t* A, int lda, const float* W, int ldw, int K, Epi epi) {
    __shared__ float As[16][65];
    __shared__ float Ws[16][64];
    const int tx = threadIdx.x & 15, ty = threadIdx.x >> 4;
    const int m0 = blockIdx.y * 64, n0 = blockIdx.x * 64;
    float acc[4][4];
#pragma unroll
    for (int i = 0; i < 4; ++i)
#pragma unroll
        for (int j = 0; j < 4; ++j) acc[i][j] = 0.f;
    for (int k0 = 0; k0 < K; k0 += 16) {
#pragma unroll
        for (int i = 0; i < 4; ++i) { int idx = threadIdx.x + i * 256; int r = idx >> 4, kk = idx & 15; As[kk][r] = bf2f(A[(size_t)(m0 + r) * lda + k0 + kk]); }
#pragma unroll
        for (int i = 0; i < 4; ++i) { int idx = threadIdx.x + i * 256; int kk = idx >> 6, cc = idx & 63; Ws[kk][cc] = W[(size_t)(k0 + kk) * ldw + n0 + cc]; }
        __syncthreads();
#pragma unroll
        for (int kk = 0; kk < 16; ++kk) {
            float a[4], b[4];
#pragma unroll
            for (int i = 0; i < 4; ++i) a[i] = As[kk][ty * 4 + i];
#pragma unroll
            for (int j = 0; j < 4; ++j) b[j] = Ws[kk][tx * 4 + j];
#pragma unroll
            for (int i = 0; i < 4; ++i)
#pragma unroll
                for (int j = 0; j < 4; ++j) acc[i][j] += a[i] * b[j];
        }
        __syncthreads();
    }
#pragma unroll
    for (int i = 0; i < 4; ++i)
#pragma unroll
        for (int j = 0; j < 4; ++j) epi(m0 + ty * 4 + i, n0 + tx * 4 + j, acc[i][j]);
}
struct EpiIn {
    bf16_t* AG; bf16_t* P;
    __device__ void operator()(int m, int n, float v) const {
        if (n < SW) { int b = m / SEQ, t = m % SEQ, g = n / GH, h = n % GH;
            AG[((size_t)g * AGR + b * NCL + t / TCH) * AGK + (t % TCH) * GH + h] = f2bf(v); }
        else P[(size_t)m * PW + (n - SW)] = f2bf(n >= 2048 ? sigmoidf_(v) : v);
    }
};
struct EpiInCtx {
    bf16_t* AG;
    __device__ void operator()(int m, int n, float v) const {
        int b = m / CTXL, t = m % CTXL, g = n / GH, h = n % GH;
        AG[((size_t)g * AGR + NB * NCL + b * NCC + t / TCH) * AGK + (t % TCH) * GH + h] = f2bf(v);
    }
};
struct EpiGluN { const bf16_t* Z; const float* bias; bf16_t* YA;
    __device__ void operator()(int m, int n, float v) const { float z = bf2f(Z[(size_t)m * SW + n]); YA[(size_t)m * SW + n] = f2bf(z * sigmoidf_(v + bias[n])); } };
struct EpiProjAN { const bf16_t* P; bf16_t* MG;
    __device__ void operator()(int m, int n, float v) const { float ga = bf2f(P[(size_t)m * PW + 1536 + n]); MG[(size_t)m * D + n] = f2bf(ga * v); } };
struct EpiProjBN { const bf16_t* P; bf16_t* MG;
    __device__ void operator()(int m, int n, float v) const { float gb = bf2f(P[(size_t)m * PW + 2560 + n]); MG[(size_t)m * D + n] = f2bf(bf2f(MG[(size_t)m * D + n]) + gb * v); } };
struct EpiOutN { const float* x; const float* MOD; const float* n2g; float* X1; bf16_t* X1S;
    __device__ void operator()(int m, int n, float v) const { int b = m / SEQ; const float* md = MOD + (size_t)b * 6 * D;
        float x1 = x[(size_t)m * D + n] + md[2 * D + n] * v; X1[(size_t)m * D + n] = x1;
        X1S[(size_t)m * D + n] = f2bf(x1 * n2g[n] * (1.f + md[4 * D + n])); } };
struct EpiUpN { const float* SS1; const float* BIASUP; bf16_t* UP; int row0; int pad;
    __device__ void operator()(int m, int n, float v) const { int mg = row0 + m; int b = mg / SEQ;
        float r = rsqrtf(SS1[mg] / D + EPS); UP[(size_t)m * F2 + n] = f2bf(v * r + BIASUP[(size_t)b * F2 + n]); } };
struct EpiDownN { const float* MOD; float* X; int row0; int pad;
    __device__ void operator()(int m, int n, float v) const { int mg = row0 + m; int b = mg / SEQ;
        X[(size_t)mg * D + n] += MOD[(size_t)b * 6 * D + 5 * D + n] * v; } };

__global__ void __launch_bounds__(64) k_ssm(const bf16_t* AG, const float* lam_re, const float* lam_im, const float* log_dt,
                                           const float* b_re, const float* b_im, const float* c_re, const float* c_im, const float* dsk,
                                           float* YF, bf16_t* Z) {
    const int b = blockIdx.x, g = blockIdx.y, p = threadIdx.x;
    float* yf = YF + ((size_t)(b * NG + g) * SEQ) * GH;
    for (int dir = 0; dir < 2; ++dir) {
        const float lr = lam_re[(dir * NG + g) * PS + p], li = lam_im[(dir * NG + g) * PS + p];
        const float dt = expf(log_dt[dir * NG + g]);
        float ar, ai, qr, qi; ssm_disc(lr, li, dt, ar, ai, qr, qi);
        float br[GH], bi[GH], cr[GH], ci[GH];
#pragma unroll
        for (int h = 0; h < GH; ++h) {
            const float tr = b_re[(((size_t)dir * NG + g) * PS + p) * GH + h], ti = b_im[(((size_t)dir * NG + g) * PS + p) * GH + h];
            br[h] = qr * tr - qi * ti; bi[h] = qr * ti + qi * tr;
            cr[h] = c_re[(((size_t)dir * NG + g) * GH + h) * PS + p]; ci[h] = c_im[(((size_t)dir * NG + g) * GH + h) * PS + p];
        }
        float sr = 0.f, si = 0.f;
        for (int n = 0; n < CTXL + SEQ; ++n) {
            const bf16_t* up; int t = 0; bool lat;
            if (n < CTXL) { int j = dir == 0 ? n : CTXL - 1 - n; lat = false;
                up = AG + ((size_t)g * AGR + NB * NCL + b * NCC + j / TCH) * AGK + (j % TCH) * GH; }
            else { t = dir == 0 ? n - CTXL : SEQ - 1 - (n - CTXL); lat = true;
                up = AG + ((size_t)g * AGR + b * NCL + t / TCH) * AGK + (t % TCH) * GH; }
            float u[GH];
#pragma unroll
            for (int h = 0; h < GH; ++h) u[h] = bf2f(up[h]);
            float bur = 0.f, bui = 0.f;
#pragma unroll
            for (int h = 0; h < GH; ++h) { bur += br[h] * u[h]; bui += bi[h] * u[h]; }
            const float nr = ar * sr - ai * si + bur, ni = ar * si + ai * sr + bui; sr = nr; si = ni;
            if (lat) {
                float mine = 0.f;
#pragma unroll
                for (int h = 0; h < GH; ++h) { float v = wave_sum(cr[h] * sr - ci[h] * si); if (p == h) mine = v; }
                if (p < GH) {
                    if (dir == 0) yf[(size_t)t * GH + p] = mine;
                    else { float uu = 0.f;
#pragma unroll
                        for (int h = 0; h < GH; ++h) if (p == h) uu = u[h];
                        float y = dsk[g * GH + p] * uu + yf[(size_t)t * GH + p] + mine;
                        Z[((size_t)b * SEQ + t) * SW + g * GH + p] = f2bf(gelu_tanh(y)); }
                }
            }
        }
    }
}
__global__ void k_ybr(const bf16_t* P, const float* sw, bf16_t* YBR) {
    size_t idx = (size_t)blockIdx.x * blockDim.x + threadIdx.x; if (idx >= (size_t)M * SW) return;
    int m = (int)(idx / SW), ch = (int)(idx % SW); int t = m % SEQ;
    float acc = 0.f;
#pragma unroll
    for (int k = 0; k < 3; ++k) { int tt = t + k - 1; if (tt < 0 || tt >= SEQ) continue; size_t mm = (size_t)(m + k - 1);
        acc += sw[k * SW + ch] * bf2f(P[mm * PW + 512 + ch]) * bf2f(P[mm * PW + 1024 + ch]); }
    YBR[idx] = f2bf(bf2f(P[(size_t)m * PW + ch]) * acc);
}
__global__ void k_rowss(const float* X, float* SS) {
    int row = blockIdx.x * (blockDim.x / 64) + (threadIdx.x >> 6); int lane = threadIdx.x & 63; if (row >= M) return;
    float ss = 0.f; for (int k = lane; k < D; k += 64) { float v = X[(size_t)row * D + k]; ss += v * v; }
    ss = wave_sum(ss); if (lane == 0) SS[row] = ss;
}
__global__ void k_biasup(const float* MOD, const float* wup, float* BIASUP) {
    int n = blockIdx.x * blockDim.x + threadIdx.x; int b = blockIdx.y; if (n >= F2) return;
    const float* sh2 = MOD + (size_t)b * 6 * D + 3 * D; float acc = 0.f;
    for (int k = 0; k < D; ++k) acc += sh2[k] * wup[(size_t)k * F2 + n];
    BIASUP[(size_t)b * F2 + n] = acc;
}
__global__ void k_conv(const bf16_t* UP, const float* cw, bf16_t* ACT) {
    size_t idx = (size_t)blockIdx.x * blockDim.x + threadIdx.x; if (idx >= (size_t)HALF_ROWS * FH) return;
    int m = (int)(idx / FH), j = (int)(idx % FH); int t = m % SEQ; int r = t / 64, c = t % 64;
    float a = 0.f, v = 0.f;
#pragma unroll
    for (int ky = 0; ky < 3; ++ky)
#pragma unroll
        for (int kx = 0; kx < 3; ++kx) { int rr = r + ky - 1, cc = c + kx - 1; if (rr < 0 || rr >= 32 || cc < 0 || cc >= 64) continue;
            size_t mm = (size_t)(m + (ky - 1) * 64 + (kx - 1));
            a += cw[(ky * 3 + kx) * F2 + j] * bf2f(UP[mm * F2 + j]); v += cw[(ky * 3 + kx) * F2 + FH + j] * bf2f(UP[mm * F2 + FH + j]); }
    ACT[idx] = f2bf(siluf_(a) * v);
}
__global__ void k_final(float* X, const float* fg) {
    int row = blockIdx.x * (blockDim.x / 64) + (threadIdx.x >> 6); int lane = threadIdx.x & 63; if (row >= M) return;
    float* xr = X + (size_t)row * D; float ss = 0.f;
    for (int k = lane; k < D; k += 64) { float v = xr[k]; ss += v * v; }
    ss = wave_sum(ss); float r = rsqrtf(ss / D + EPS);
    for (int k = lane; k < D; k += 64) xr[k] = xr[k] * r * fg[k];
}

namespace pg8 {
constexpr int BM = 256, BK = 64, HALF = 128, HTB = HALF * BK * 2, STAGE_BYTES = 8 * HTB, NXCD = 8, WGM = 8;
__host__ __device__ __forceinline__ int lds_byte(int r, int c) { const int st = (r >> 4) * 2 + (c >> 5), rr = r & 15, cc = c & 31, ob = rr * 64 + cc * 2; return st * 1024 + (ob ^ (((ob >> 9) & 1) << 5)); }
__host__ __device__ __forceinline__ void stage_rc(int b, int& R, int& C) { const int st = b / 1024, sb = b % 1024, swz = sb ^ (((sb >> 9) & 1) << 5); R = (st >> 1) * 16 + swz / 64; C = (st & 1) * 32 + (swz % 64) / 2; }
__host__ __device__ __forceinline__ int perm32(int rho) { const int n = rho >> 4, i = rho & 15; return 8 * (i >> 2) + 4 * n + (i & 3); }

struct Unit { const char* A; const char* B; int pm, pn, z; };

struct PlainSched {
    const char* A; const char* B; size_t a_tile, b_tile; int nM, nN, nwg, G, c, z;
    __device__ void init(const void* A_, int lda, const void* B_, int ldb, int Mr, int N, int G_, int c_, int z_) {
        A = (const char*)A_; B = (const char*)B_; a_tile = (size_t)BM * lda * 2; b_tile = (size_t)BM * ldb * 2; nM = Mr / BM; nN = N / BM; nwg = nM * nN; G = G_; c = c_; z = z_; }
    __device__ bool next(int i, Unit& u) const {
        const long L = (long)i * G + c; if (L >= nwg) return false;
        int wgid = (int)L; { const int q = nwg / NXCD, r = nwg % NXCD, xcd = wgid % NXCD, off = wgid / NXCD; wgid = (xcd < r ? xcd * (q + 1) : r * (q + 1) + (xcd - r) * q) + off; }
        const int nig = WGM * nN, gid = wgid / nig, fm = gid * WGM, gsz = (nM - fm) < WGM ? (nM - fm) : WGM;
        u.pm = fm + ((wgid % nig) % gsz); u.pn = (wgid % nig) / gsz; u.z = z;
        u.A = A + (size_t)u.pm * a_tile; u.B = B + (size_t)u.pn * b_tile; return true;
    }
};
struct BatchSched {
    const char* A; const char* B; size_t a_tile, b_tile, a_z, b_z; int nM, nN, per_z, zpx, gpx, x, j;
    __device__ void init(const void* A_, int lda, size_t a_z_, const void* B_, int ldb, size_t b_z_, int nM_, int nN_, int nZ, int G, int c) {
        A = (const char*)A_; B = (const char*)B_; a_tile = (size_t)BM * lda * 2; b_tile = (size_t)BM * ldb * 2; a_z = a_z_; b_z = b_z_;
        nM = nM_; nN = nN_; per_z = nM_ * nN_; zpx = nZ / NXCD; gpx = G / NXCD; x = c % NXCD; j = c / NXCD; }
    __device__ bool next(int i, Unit& u) const {
        const int q = i * gpx + j; if (j >= gpx || q >= zpx * per_z) return false;
        const int z = x * zpx + q / per_z, r = q % per_z; u.pm = r % nM; u.pn = r / nM; u.z = z;
        u.A = A + (size_t)z * a_z + (size_t)u.pm * a_tile; u.B = B + (size_t)z * b_z + (size_t)u.pn * b_tile; return true;
    }
};

template <class Epi, class Sched>
__device__ __forceinline__ void gemm_phase(LAS unsigned char* lds, const int K, const int lda, const int ldb, const Sched& S, const Epi& E) {
    const int tid = threadIdx.x, wid = __builtin_amdgcn_readfirstlane(tid >> 6), lane = tid & 63, wr = wid >> 2, wc = wid & 3, fr = lane & 15, fq = lane >> 4;
    const int nt = K / BK;
    unsigned voffA[2], voffB[2];
#pragma unroll
    for (int i = 0; i < 2; ++i) { int R, C; stage_rc(tid * 16 + i * 8192, R, C); const int Rb = Epi::PERM ? ((R & ~31) + perm32(R & 31)) : R;
        voffA[i] = (unsigned)(R * lda + C) * 2u; voffB[i] = (unsigned)(Rb * ldb + C) * 2u; }
    const size_t kstep = (size_t)(BK * 2);
    const size_t hstepA = (size_t)HALF * lda * 2, hstepB = (size_t)HALF * ldb * 2;
    const unsigned ldsw = (unsigned)wid * 1024u;
    const int aoff = lds_byte(wr * 64 + fr, fq * 8), boff = lds_byte(wc * 32 + fr, fq * 8);
#define PG8_SA(b, h) (((b) * 2 + (h)) * HTB)
#define PG8_SB(b, h) ((4 + (b) * 2 + (h)) * HTB)
#define PG8_STAGE(bufoff, gbase, voff) do { _Pragma("unroll") for (int _i = 0; _i < 2; ++_i) \
        __builtin_amdgcn_global_load_lds((const unsigned*)((const char*)(gbase) + (voff)[_i]), (LAS unsigned*)(lds + (bufoff) + ldsw + _i * 8192), 16, 0, 0); } while (0)
#define PG8_LDA(dst, b, h) do { _Pragma("unroll") for (int m = 0; m < 4; ++m) _Pragma("unroll") for (int k = 0; k < 2; ++k) dst[m][k] = *(const LAS bf16x8*)(lds + PG8_SA(b, h) + aoff + m * 2048 + k * 1024); } while (0)
#define PG8_LDB(dst, b, h) do { _Pragma("unroll") for (int n = 0; n < 2; ++n) _Pragma("unroll") for (int k = 0; k < 2; ++k) dst[n][k] = *(const LAS bf16x8*)(lds + PG8_SB(b, h) + boff + n * 2048 + k * 1024); } while (0)
#define PG8_MMA(ai, bj, At, Bt) do { __builtin_amdgcn_s_setprio(1); _Pragma("unroll") for (int m = 0; m < 4; ++m) _Pragma("unroll") for (int n = 0; n < 2; ++n) _Pragma("unroll") for (int k = 0; k < 2; ++k) \
        acc[ai][bj][m][n] = __builtin_amdgcn_mfma_f32_16x16x32_bf16(Bt[n][k], At[m][k], acc[ai][bj][m][n], 0, 0, 0); __builtin_amdgcn_s_setprio(0); } while (0)
#define PG8_WAIT_V(n) asm volatile("s_waitcnt vmcnt(" #n ")" ::: "memory")
#define PG8_WAIT_L(n) asm volatile("s_waitcnt lgkmcnt(" #n ")" ::: "memory")
#define PG8_BAR __builtin_amdgcn_s_barrier()
#define PG8_SCHED __builtin_amdgcn_sched_barrier(0)
    Unit cur, nxt; int ui = 0;
    if (!S.next(0, cur)) return;
    f32x4 acc[2][2][4][2];
#pragma unroll
    for (int a = 0; a < 2; ++a)
#pragma unroll
        for (int b = 0; b < 2; ++b)
#pragma unroll
            for (int m = 0; m < 4; ++m)
#pragma unroll
                for (int n = 0; n < 2; ++n) acc[a][b][m][n] = (f32x4){0.f, 0.f, 0.f, 0.f};
    bf16x8 At[4][2], B0[2][2], B1[2][2];
    const char* cA = cur.A; const char* cB = cur.B;
    PG8_STAGE(PG8_SB(0, 0), cB, voffB); PG8_STAGE(PG8_SB(0, 1), cB + hstepB, voffB); PG8_STAGE(PG8_SA(0, 0), cA, voffA); PG8_STAGE(PG8_SA(0, 1), cA + hstepA, voffA);
    if (wr == 1) PG8_BAR;
    PG8_WAIT_V(2); PG8_BAR;
    PG8_STAGE(PG8_SB(1, 0), cB + kstep, voffB); PG8_STAGE(PG8_SA(1, 0), cA + kstep, voffA); PG8_STAGE(PG8_SB(1, 1), cB + hstepB + kstep, voffB);
    PG8_WAIT_V(6); PG8_BAR;
    for (;;) {
        const bool has_next = S.next(ui + 1, nxt);
        const char* nA = has_next ? nxt.A : cA; const char* nB = has_next ? nxt.B : cB;
        for (int t = 0; t < nt; t += 2) {
            const bool last = (t == nt - 2);
            const char* a1 = cA + (size_t)(t + 1) * kstep;
            const char* a2 = last ? nA : cA + (size_t)(t + 2) * kstep; const char* b2 = last ? nB : cB + (size_t)(t + 2) * kstep;
            const char* a3 = a2 + kstep; const char* b3 = b2 + kstep;
            PG8_LDB(B0, 0, 0); PG8_LDB(B1, 0, 1); PG8_SCHED; PG8_LDA(At, 0, 0); PG8_STAGE(PG8_SA(1, 1), a1 + hstepA, voffA);
            PG8_WAIT_V(8); PG8_WAIT_L(0); PG8_BAR; PG8_MMA(0, 0, At, B0); PG8_MMA(0, 1, At, B1); PG8_BAR; PG8_SCHED;
            PG8_LDA(At, 0, 1); PG8_STAGE(PG8_SB(0, 0), b2, voffB); PG8_STAGE(PG8_SB(0, 1), b2 + hstepB, voffB); PG8_STAGE(PG8_SA(0, 0), a2, voffA);
            PG8_WAIT_V(8); PG8_WAIT_L(0); PG8_BAR; PG8_MMA(1, 0, At, B0); PG8_MMA(1, 1, At, B1); PG8_BAR; PG8_SCHED;
            PG8_LDB(B0, 1, 0); PG8_LDB(B1, 1, 1); PG8_SCHED; PG8_LDA(At, 1, 0); PG8_STAGE(PG8_SA(0, 1), a2 + hstepA, voffA);
            PG8_WAIT_V(8); PG8_WAIT_L(0); PG8_BAR; PG8_MMA(0, 0, At, B0); PG8_MMA(0, 1, At, B1); PG8_BAR; PG8_SCHED;
            PG8_LDA(At, 1, 1); PG8_STAGE(PG8_SB(1, 0), b3, voffB); PG8_STAGE(PG8_SB(1, 1), b3 + hstepB, voffB); PG8_STAGE(PG8_SA(1, 0), a3, voffA);
            PG8_WAIT_V(8); PG8_WAIT_L(0); PG8_BAR; PG8_MMA(1, 0, At, B0); PG8_MMA(1, 1, At, B1); PG8_BAR; PG8_SCHED;
        }
        if (wr == 0) PG8_BAR;
        E(acc, cur, wr, wc, fr, fq);
        if (!has_next) break;
#pragma unroll
        for (int a = 0; a < 2; ++a)
#pragma unroll
            for (int b = 0; b < 2; ++b)
#pragma unroll
                for (int m = 0; m < 4; ++m)
#pragma unroll
                    for (int n = 0; n < 2; ++n) acc[a][b][m][n] = (f32x4){0.f, 0.f, 0.f, 0.f};
        cur = nxt; cA = nA; cB = nB; ++ui;
        if (wr == 1) PG8_BAR;
    }
    PG8_WAIT_V(0);
    PG8_BAR;
#undef PG8_SA
#undef PG8_SB
#undef PG8_STAGE
#undef PG8_LDA
#undef PG8_LDB
#undef PG8_MMA
#undef PG8_WAIT_V
#undef PG8_WAIT_L
#undef PG8_BAR
#undef PG8_SCHED
}
}
using pg8::Unit;

#define EPI_ROWS(...) _Pragma("unroll") for (int ai = 0; ai < 2; ++ai) _Pragma("unroll") for (int m = 0; m < 4; ++m) { const int row = u.pm * 256 + ai * 128 + wr * 64 + m * 16 + fr; __VA_ARGS__ }
#define EPI_COLS(...) _Pragma("unroll") for (int bj = 0; bj < 2; ++bj) { const int col0 = u.pn * 256 + bj * 128 + wc * 32 + 8 * fq; const f32x4 v0 = acc[ai][bj][m][0], v1 = acc[ai][bj][m][1]; __VA_ARGS__ }

struct EpiGemm1 {
    static constexpr bool PERM = true;
    bf16_t* AG; bf16_t* P;
    __device__ __forceinline__ void operator()(const f32x4 (&acc)[2][2][4][2], const Unit& u, int wr, int wc, int fr, int fq) const {
        EPI_ROWS(
            EPI_COLS(
                if (u.pn < 2) {
                    const int g = col0 >> 4, hf = (col0 >> 3) & 1; size_t arow;
                    if (u.z == 0) { const int b = row >> 11, t = row & 2047; arow = (size_t)g * AGR + b * NCL + (t >> 6); }
                    else { const int b = row >> 8, t = row & 255; arow = (size_t)g * AGR + NB * NCL + b * NCC + (t >> 6); }
                    *(u32x4*)(AG + arow * AGK + (row & 63) * GH + hf * 8) = pack8(v0, v1);
                } else {
                    f32x4 a = v0, b = v1;
                    if (u.pn >= 8) {
_Pragma("unroll")
                        for (int e = 0; e < 4; ++e) { a[e] = fsig(a[e]); b[e] = fsig(b[e]); } }
                    *(u32x4*)(P + (size_t)row * PW + (col0 - SW)) = pack8(a, b);
                }
            )
        )
    }
};
struct EpiE {
    static constexpr bool PERM = true;
    float* E;
    __device__ __forceinline__ void operator()(const f32x4 (&acc)[2][2][4][2], const Unit& u, int wr, int wc, int fr, int fq) const {
        EPI_ROWS(
            if (row < AGR) {
                EPI_COLS( float* dst = E + ((size_t)u.z * AGR + row) * 256 + col0; *(f32x4*)dst = v0; *(f32x4*)(dst + 4) = v1; )
            }
        )
    }
};
struct EpiY {
    static constexpr bool PERM = true;
    bf16_t* Z;
    __device__ __forceinline__ void operator()(const f32x4 (&acc)[2][2][4][2], const Unit& u, int wr, int wc, int fr, int fq) const {
        EPI_ROWS(
            const int b = row >> 5; const int c = row & 31;
            EPI_COLS(
                const int i = col0 >> 4, hf = (col0 >> 3) & 1; f32x4 a, bb;
_Pragma("unroll")
                for (int e = 0; e < 4; ++e) { a[e] = fgelu(v0[e]); bb[e] = fgelu(v1[e]); }
                *(u32x4*)(Z + ((size_t)b * SEQ + c * TCH + i) * SW + u.z * GH + hf * 8) = pack8(a, bb);
            )
        )
    }
};
struct EpiGlu {
    static constexpr bool PERM = true;
    const bf16_t* Z; const float* bias; bf16_t* YA;
    __device__ __forceinline__ void operator()(const f32x4 (&acc)[2][2][4][2], const Unit& u, int wr, int wc, int fr, int fq) const {
        f32x4 bv[2][2];
#pragma unroll
        for (int bj = 0; bj < 2; ++bj) { const int col0 = u.pn * 256 + bj * 128 + wc * 32 + 8 * fq; bv[bj][0] = *(const f32x4*)(bias + col0); bv[bj][1] = *(const f32x4*)(bias + col0 + 4); }
        EPI_ROWS(
            EPI_COLS(
                const u32x4 zw = *(const u32x4*)(Z + (size_t)row * SW + col0); f32x4 z0, z1; unpack8(zw, z0, z1); f32x4 a, b;
_Pragma("unroll")
                for (int e = 0; e < 4; ++e) { a[e] = z0[e] * fsig(v0[e] + bv[bj][0][e]); b[e] = z1[e] * fsig(v1[e] + bv[bj][1][e]); }
                *(u32x4*)(YA + (size_t)row * SW + col0) = pack8(a, b);
            )
            if (m & 1) asm volatile("" ::: "memory");
        )
    }
};
template <bool SECOND> struct EpiProj {
    static constexpr bool PERM = true;
    const bf16_t* P; bf16_t* MG;
    __device__ __forceinline__ void operator()(const f32x4 (&acc)[2][2][4][2], const Unit& u, int wr, int wc, int fr, int fq) const {
        EPI_ROWS(
            EPI_COLS(
                const u32x4 gw = *(const u32x4*)(P + (size_t)row * PW + (SECOND ? 2560 : 1536) + col0); f32x4 g0, g1; unpack8(gw, g0, g1);
                f32x4 a = g0 * v0, b = g1 * v1;
                if (SECOND) { const u32x4 ow = *(const u32x4*)(MG + (size_t)row * D + col0); f32x4 o0, o1; unpack8(ow, o0, o1); a += o0; b += o1; }
                *(u32x4*)(MG + (size_t)row * D + col0) = pack8(a, b);
            )
            if (m & 1) asm volatile("" ::: "memory");
        )
    }
};
struct EpiOut {
    static constexpr bool PERM = true;
    const float* x; const float* MOD; const float* n2g; float* X1; bf16_t* X1S; float* SS1;
    __device__ __forceinline__ void operator()(const f32x4 (&acc)[2][2][4][2], const Unit& u, int wr, int wc, int fr, int fq) const {
        const float* md = MOD + (size_t)(u.pm >> 3) * 6 * D;
        f32x4 g1v[2][2], fac[2][2];
#pragma unroll
        for (int bj = 0; bj < 2; ++bj)
#pragma unroll
            for (int n = 0; n < 2; ++n) { const int col = u.pn * 256 + bj * 128 + wc * 32 + 8 * fq + 4 * n;
                g1v[bj][n] = *(const f32x4*)(md + 2 * D + col); fac[bj][n] = *(const f32x4*)(n2g + col) * (*(const f32x4*)(md + 4 * D + col) + 1.f); }
        EPI_ROWS(
            float ss = 0.f;
            EPI_COLS(
                const size_t off = (size_t)row * D + col0;
                const f32x4 a = *(const f32x4*)(x + off) + g1v[bj][0] * v0, b = *(const f32x4*)(x + off + 4) + g1v[bj][1] * v1;
                *(f32x4*)(X1 + off) = a; *(f32x4*)(X1 + off + 4) = b;
                ss += (a[0] * a[0] + a[1] * a[1]) + (a[2] * a[2] + a[3] * a[3]) + (b[0] * b[0] + b[1] * b[1]) + (b[2] * b[2] + b[3] * b[3]);
                *(u32x4*)(X1S + off) = pack8(a * fac[bj][0], b * fac[bj][1]);
            )
            ss += __shfl_xor(ss, 16); ss += __shfl_xor(ss, 32);
            if (fq == 0) unsafeAtomicAdd(SS1 + row, ss);
            if (m & 1) asm volatile("" ::: "memory");
        )
    }
};
struct EpiUp {
    static constexpr bool PERM = true;
    const float* SS1; const float* BIASUP; bf16_t* UP; int row0;
    __device__ __forceinline__ void operator()(const f32x4 (&acc)[2][2][4][2], const Unit& u, int wr, int wc, int fr, int fq) const {
        const float* bu = BIASUP + (size_t)((row0 >> 11) + (u.pm >> 3)) * F2;
        f32x4 bv[2][2];
#pragma unroll
        for (int bj = 0; bj < 2; ++bj) { const int col0 = u.pn * 256 + bj * 128 + wc * 32 + 8 * fq; bv[bj][0] = *(const f32x4*)(bu + col0); bv[bj][1] = *(const f32x4*)(bu + col0 + 4); }
        EPI_ROWS(
            const float rs = rsqrtf(SS1[row0 + row] * (1.f / D) + EPS);
            EPI_COLS( *(u32x4*)(UP + (size_t)row * F2 + col0) = pack8(v0 * rs + bv[bj][0], v1 * rs + bv[bj][1]); )
        )
    }
};
struct EpiDown {
    static constexpr bool PERM = true;
    const float* MOD; float* X; float* SS2; int row0;
    __device__ __forceinline__ void operator()(const f32x4 (&acc)[2][2][4][2], const Unit& u, int wr, int wc, int fr, int fq) const {
        const float* md = MOD + (size_t)((row0 >> 11) + (u.pm >> 3)) * 6 * D + 5 * D;
        f32x4 g2v[2][2];
#pragma unroll
        for (int bj = 0; bj < 2; ++bj) { const int col0 = u.pn * 256 + bj * 128 + wc * 32 + 8 * fq; g2v[bj][0] = *(const f32x4*)(md + col0); g2v[bj][1] = *(const f32x4*)(md + col0 + 4); }
        EPI_ROWS(
            float ss = 0.f;
            EPI_COLS(
                const size_t off = (size_t)(row0 + row) * D + col0;
                const f32x4 a = *(const f32x4*)(X + off) + g2v[bj][0] * v0, b = *(const f32x4*)(X + off + 4) + g2v[bj][1] * v1;
                *(f32x4*)(X + off) = a; *(f32x4*)(X + off + 4) = b;
                ss += (a[0] * a[0] + a[1] * a[1]) + (a[2] * a[2] + a[3] * a[3]) + (b[0] * b[0] + b[1] * b[1]) + (b[2] * b[2] + b[3] * b[3]);
            )
            ss += __shfl_xor(ss, 16); ss += __shfl_xor(ss, 32);
            if (fq == 0) unsafeAtomicAdd(SS2 + row0 + row, ss);
            if (m & 1) asm volatile("" ::: "memory");
        )
    }
};

constexpr int NWAVES = 8, NTHREADS = 512;
constexpr int LDS_BYTES = 147456;
#define LDS_WAIT() asm volatile("s_waitcnt lgkmcnt(0)" ::: "memory")

enum Phase { PH_PRO = 0, PH_NORM1, PH_GEMM1, PH_SSME, PH_SCAN, PH_SSMY, PH_GLU, PH_PROJ, PH_OUT, PH_UP0, PH_CONV0, PH_DOWN0UP1, PH_CONV1, PH_DOWN1, PH_FINAL, PH_COUNT };

struct Args { const float* in[27]; float* out; unsigned char* ws; int ph_lo, ph_hi; };

__device__ __forceinline__ void transpose_item(const float* W, int K, int N, bf16_t* WT, LAS float* scr, int item, int lane) {
    const int nblk = N / 32, kb = item / nblk, nb = item % nblk, k0 = 64 * kb, n0 = 32 * nb;
#pragma unroll 8
    for (int i = 0; i < 32; ++i) { const int kk = 2 * i + (lane >> 5); scr[kk * 33 + (lane & 31)] = W[(size_t)(k0 + kk) * N + n0 + (lane & 31)]; }
    LDS_WAIT(); asm volatile("" ::: "memory");
    const int c = lane & 7;
#pragma unroll
    for (int j = 0; j < 4; ++j) { const int n = (lane >> 3) + 8 * j; const LAS float* s = scr + (8 * c) * 33 + n;
        u32x4 o; o.x = cvt_pk_bf16(s[0 * 33], s[1 * 33]); o.y = cvt_pk_bf16(s[2 * 33], s[3 * 33]); o.z = cvt_pk_bf16(s[4 * 33], s[5 * 33]); o.w = cvt_pk_bf16(s[6 * 33], s[7 * 33]);
        *(u32x4*)(WT + (size_t)(n0 + n) * K + k0 + 8 * c) = o; }
    LDS_WAIT(); asm volatile("" ::: "memory");
}
template <int R, bool SILU, class RowPtr>
__device__ __forceinline__ void gemv_task(LAS float* scr, const RowPtr& rp, const float* W, int ldw, int n0, int k0, int nk, float* OUT, int ldo, const float* bias, int lane) {
    float acc[R];
#pragma unroll
    for (int r = 0; r < R; ++r) acc[r] = 0.f;
    const int n = n0 + lane;
    for (int ks = 0; ks < nk; ks += 64) {
#pragma unroll
        for (int r = 0; r < R; ++r) { float v = rp(r)[k0 + ks + lane]; if (SILU) v = v * fsig(v); scr[lane * 36 + r] = v; }
        LDS_WAIT(); asm volatile("" ::: "memory");
#pragma unroll 4
        for (int kk = 0; kk < 64; ++kk) { const float w = W[(size_t)(k0 + ks + kk) * ldw + n];
#pragma unroll
            for (int r = 0; r < R; ++r) acc[r] += scr[kk * 36 + r] * w; }
        LDS_WAIT(); asm volatile("" ::: "memory");
    }
    const float bz = (bias && k0 == 0) ? bias[n] : 0.f;
#pragma unroll
    for (int r = 0; r < R; ++r) unsafeAtomicAdd(OUT + (size_t)r * ldo + n, acc[r] + bz);
}
struct ModRows { const float* c; const float* c_ctx; __device__ __forceinline__ const float* operator()(int r) const { return r < NB ? c + (size_t)r * D : c_ctx; } };
struct Sh2Rows { const float* MOD; __device__ __forceinline__ const float* operator()(int r) const { return MOD + (size_t)r * 6 * D + 3 * D; } };

__global__ void __launch_bounds__(NTHREADS, 2) mega(Args a) {
    extern __shared__ __attribute__((aligned(16))) unsigned char lds_raw[];
    LAS unsigned char* lds = (LAS unsigned char*)lds_raw;
    cg::grid_group grid = cg::this_grid();
    const int tid = threadIdx.x, lane = tid & 63, wave = __builtin_amdgcn_readfirstlane(tid >> 6);
    const int G = gridDim.x, bx = blockIdx.x;
    const int gw = bx * NWAVES + wave, NGW = G * NWAVES;
    const int gt = bx * NTHREADS + tid, NGT = G * NTHREADS;
    unsigned char* ws = a.ws;
    const float* x = a.in[0]; const float* cvec = a.in[1]; const float* ctx = a.in[2]; const float* c_ctx = a.in[3];
    const float* mod_w = a.in[4]; const float* mod_b = a.in[5]; const float* n1g = a.in[6]; const float* n2g = a.in[7];
    const float* w_in = a.in[8]; const float* lam_re = a.in[9]; const float* lam_im = a.in[10]; const float* log_dt = a.in[11];
    const float* b_re = a.in[12]; const float* b_im = a.in[13]; const float* c_re = a.in[14]; const float* c_im = a.in[15];
    const float* ssm_d = a.in[16]; const float* glu_w = a.in[17]; const float* glu_b = a.in[18]; const float* sconv_w = a.in[19];
    const float* proj_a = a.in[20]; const float* proj_b = a.in[21]; const float* w_out = a.in[22]; const float* w_up = a.in[23];
    const float* conv_w = a.in[24]; const float* w_down = a.in[25]; const float* final_g = a.in[26];
    float* out = a.out;
    float* MOD = (float*)(ws + WS_MOD); float* BIASUP = (float*)(ws + WS_BIASUP); float* SS1 = (float*)(ws + WS_SS1); float* SS2 = (float*)(ws + WS_SS2);
    bf16_t* WIN = (bf16_t*)(ws + WS_WIN); bf16_t* WGLU = (bf16_t*)(ws + WS_WGLU); bf16_t* WPA = (bf16_t*)(ws + WS_WPA); bf16_t* WPB = (bf16_t*)(ws + WS_WPB);
    bf16_t* WOUT = (bf16_t*)(ws + WS_WOUT); bf16_t* WUP = (bf16_t*)(ws + WS_WUP); bf16_t* WDOWN = (bf16_t*)(ws + WS_WDOWN);
    bf16_t* OP = (bf16_t*)(ws + WS_OP); bf16_t* WE = (bf16_t*)(ws + WS_WE);
    bf16_t* P = (bf16_t*)(ws + WS_P); bf16_t* H = (bf16_t*)(ws + WS_H); bf16_t* AG = (bf16_t*)(ws + WS_AG); float* E = (float*)(ws + WS_E);
    bf16_t* YBR = (bf16_t*)(ws + WS_YBR); bf16_t* Z = (bf16_t*)(ws + WS_Z); bf16_t* YA = (bf16_t*)(ws + WS_YA); bf16_t* MG = (bf16_t*)(ws + WS_MERGED);
    bf16_t* X1S = (bf16_t*)(ws + WS_X1S); bf16_t* UP = (bf16_t*)(ws + WS_UP); bf16_t* ACT = (bf16_t*)(ws + WS_ACT);
    float* KT = (float*)(ws + WS_KT); f32x2* APW = (f32x2*)(ws + WS_APW);
    LAS float* wscr = (LAS float*)(lds + wave * 16384);

    const int lo = a.ph_lo, hi = a.ph_hi;
#define IN(k) (lo <= (k) && (k) < hi)
#define SEAM(k) do { if (IN(k) && IN((k) + 1)) grid.sync(); } while (0)

    if (IN(PH_PRO)) {
        for (int i = gt; i < NG * 2 * 65 * PS; i += NGT) {
            const int p = i & 63, e = (i >> 6) % 65, gd = i / (65 * 64), dir = gd & 1, g = gd >> 1;
            const float dt = expf(log_dt[dir * NG + g]); float pr, pi;
            ssm_apow(lam_re[(dir * NG + g) * PS + p], lam_im[(dir * NG + g) * PS + p], dt, (float)e, pr, pi);
            APW[i] = (f32x2){pr, pi};
        }
        for (int task = bx; task < NG * 8; task += G) {
            const int g = task >> 3, ts = task & 7;
            LAS f32x2* s_apw = (LAS f32x2*)lds;
            LAS f32x2* s_bb = (LAS f32x2*)(lds + 8192);
            LAS f32x2* s_cc = (LAS f32x2*)(lds + 8192 + 16384);
            for (int i = tid; i < 1024; i += NTHREADS) { const int dir = i >> 9, tt = (i >> 6) & 7, p = i & 63; const float dt = expf(log_dt[dir * NG + g]); float pr, pi;
                ssm_apow(lam_re[(dir * NG + g) * PS + p], lam_im[(dir * NG + g) * PS + p], dt, (float)(ts * 8 + tt), pr, pi); s_apw[i] = (f32x2){pr, pi}; }
            for (int i = tid; i < 2048; i += NTHREADS) { const int dir = i >> 10, p = (i >> 4) & 63, hp = i & 15; const float dt = expf(log_dt[dir * NG + g]); float ar, ai, qr, qi;
                ssm_disc(lam_re[(dir * NG + g) * PS + p], lam_im[(dir * NG + g) * PS + p], dt, ar, ai, qr, qi);
                const size_t bi = (((size_t)dir * NG + g) * PS + p) * GH + hp; const float tr = b_re[bi], ti = b_im[bi];
                s_bb[i] = (f32x2){qr * tr - qi * ti, qr * ti + qi * tr}; }
            for (int i = tid; i < 2048; i += NTHREADS) { const int dir = i >> 10, h = (i >> 6) & 15, p = i & 63; const size_t ci = (((size_t)dir * NG + g) * GH + h) * PS + p;
                s_cc[i] = (f32x2){c_re[ci], c_im[ci]}; }
            __syncthreads();
#pragma unroll 1
            for (int e = 0; e < 8; ++e) { const int o = tid + NTHREADS * e; const int dir = o >> 11, tt = (o >> 8) & 7, h = (o >> 4) & 15, hp = o & 15;
                float s = 0.f;
                for (int p = 0; p < PS; ++p) { const f32x2 cc = s_cc[(dir * 16 + h) * 64 + p], aw = s_apw[(dir * 8 + tt) * 64 + p], bb = s_bb[(dir * 64 + p) * 16 + hp];
                    const float car = cc.x * aw.x - cc.y * aw.y, cai = cc.x * aw.y + cc.y * aw.x; s += car * bb.x - cai * bb.y; }
                KT[((((size_t)g * 2 + dir) * 64 + ts * 8 + tt) * 16 + h) * 16 + hp] = s; }
            __syncthreads();
        }
        {
            constexpr int I_IN = (D / 64) * (PCOLS / 32), I_GLU = (SW / 64) * (SW / 32), I_PA = (SW / 64) * (D / 32), I_OUT = (D / 64) * (D / 32), I_UP = (D / 64) * (F2 / 32), I_DN = (FH / 64) * (D / 32);
            constexpr int NITEMS = I_IN + I_GLU + 2 * I_PA + I_OUT + I_UP + I_DN;
            for (int it = gw; it < NITEMS; it += NGW) {
                int r = it;
                if (r < I_IN) { transpose_item(w_in, D, PCOLS, WIN, wscr, r, lane); continue; } r -= I_IN;
                if (r < I_GLU) { transpose_item(glu_w, SW, SW, WGLU, wscr, r, lane); continue; } r -= I_GLU;
                if (r < I_PA) { transpose_item(proj_a, SW, D, WPA, wscr, r, lane); continue; } r -= I_PA;
                if (r < I_PA) { transpose_item(proj_b, SW, D, WPB, wscr, r, lane); continue; } r -= I_PA;
                if (r < I_OUT) { transpose_item(w_out, D, D, WOUT, wscr, r, lane); continue; } r -= I_OUT;
                if (r < I_UP) { transpose_item(w_up, D, F2, WUP, wscr, r, lane); continue; } r -= I_UP;
                transpose_item(w_down, FH, D, WDOWN, wscr, r, lane);
            }
        }
        {
            const ModRows rp{cvec, c_ctx};
            for (int task = NGW - 1 - gw; task < (6 * D / 64) * 4; task += NGW) { const int cb = task >> 2, ks = task & 3;
                gemv_task<NB + 1, true>(wscr, rp, mod_w, 6 * D, cb * 64, ks * 256, 256, MOD, 6 * D, mod_b, lane); }
        }
    }
    SEAM(PH_PRO);

    if (IN(PH_NORM1)) {
        for (int task = gw; task < NG * 256; task += NGW) {
            const int g = task >> 8, n = task & 255, dir = n >> 7, ri = (n >> 6) & 1, p = n & 63;
            const int j = lane, e = dir ? j : 63 - j;
            const f32x2 pw = APW[(((size_t)g * 2 + dir) * 65 + e) * 64 + p];
            const float dt = expf(log_dt[dir * NG + g]); float ar, ai, qr, qi;
            ssm_disc(lam_re[(dir * NG + g) * PS + p], lam_im[(dir * NG + g) * PS + p], dt, ar, ai, qr, qi);
            const float wr_ = pw.x * qr - pw.y * qi, wi_ = pw.x * qi + pw.y * qr;
            const float* br = b_re + (((size_t)dir * NG + g) * PS + p) * GH; const float* bi = b_im + (((size_t)dir * NG + g) * PS + p) * GH;
            float v[16];
#pragma unroll
            for (int hp = 0; hp < 16; ++hp) v[hp] = ri ? (wr_ * bi[hp] + wi_ * br[hp]) : (wr_ * br[hp] - wi_ * bi[hp]);
            bf16_t* dst = WE + ((size_t)g * 256 + n) * 1024 + j * 16;
            u32x4 w0, w1; w0.x = cvt_pk_bf16(v[0], v[1]); w0.y = cvt_pk_bf16(v[2], v[3]); w0.z = cvt_pk_bf16(v[4], v[5]); w0.w = cvt_pk_bf16(v[6], v[7]);
            w1.x = cvt_pk_bf16(v[8], v[9]); w1.y = cvt_pk_bf16(v[10], v[11]); w1.z = cvt_pk_bf16(v[12], v[13]); w1.w = cvt_pk_bf16(v[14], v[15]);
            *(u32x4*)dst = w0; *(u32x4*)(dst + 8) = w1;
        }
        for (int task = gw; task < NG * 1024; task += NGW) {
            const int g = task >> 10, n = task & 1023, i = n >> 4, h = n & 15;
            bf16_t* dst = OP + ((size_t)g * 1024 + n) * AGK;
            const float* kt0 = KT + (((size_t)g * 2 + 0) * 64) * 256 + h * 16; const float* kt1 = KT + (((size_t)g * 2 + 1) * 64) * 256 + h * 16;
#pragma unroll
            for (int pass = 0; pass < 2; ++pass) { const int ch = lane + 64 * pass, j = ch >> 1, hh = (ch & 1) * 8;
                f32x4 a, b;
                if (j < i) { const float* s = kt0 + (size_t)(i - j) * 256 + hh; a = *(const f32x4*)s; b = *(const f32x4*)(s + 4); }
                else if (j > i) { const float* s = kt1 + (size_t)(j - i) * 256 + hh; a = *(const f32x4*)s; b = *(const f32x4*)(s + 4); }
                else { const float* s0 = kt0 + hh; const float* s1 = kt1 + hh; a = *(const f32x4*)s0 + *(const f32x4*)s1; b = *(const f32x4*)(s0 + 4) + *(const f32x4*)(s1 + 4);
                    const float dd = ssm_d[g * GH + h];
#pragma unroll
                    for (int e = 0; e < 4; ++e) { if (hh + e == h) a[e] += dd; if (hh + 4 + e == h) b[e] += dd; } }
                *(u32x4*)(dst + ch * 8) = pack8(a, b); }
            if (lane < 32) { const int kk0 = lane * 8, dir = kk0 >> 7, ri = (kk0 >> 6) & 1, p0 = kk0 & 63; const int e = dir ? 64 - i : i + 1;
                const f32x2* pw = APW + (((size_t)g * 2 + dir) * 65 + e) * 64 + p0; const size_t ci = (((size_t)dir * NG + g) * GH + h) * PS + p0;
                float v[8];
#pragma unroll
                for (int q = 0; q < 8; ++q) { const f32x2 w = pw[q]; const float cr = c_re[ci + q], cim = c_im[ci + q]; v[q] = ri ? -(cr * w.y + cim * w.x) : (cr * w.x - cim * w.y); }
                u32x4 o; o.x = cvt_pk_bf16(v[0], v[1]); o.y = cvt_pk_bf16(v[2], v[3]); o.z = cvt_pk_bf16(v[4], v[5]); o.w = cvt_pk_bf16(v[6], v[7]);
                *(u32x4*)(dst + 1024 + kk0) = o; }
        }
        {
            const Sh2Rows rp{MOD};
            for (int task = NGW - 1 - gw; task < (F2 / 64) * 4; task += NGW) { const int cb = task >> 2, ks = task & 3;
                gemv_task<NB, false>(wscr, rp, w_up, F2, cb * 64, ks * 256, 256, BIASUP, F2, nullptr, lane); }
        }
        for (int row = gw; row < M + MC; row += NGW) {
            const float* xr; int mr;
            if (row < M) { xr = x + (size_t)row * D; mr = row >> 11; } else { xr = ctx + (size_t)(row - M) * D; mr = NB; }
            const float* sh = MOD + (size_t)mr * 6 * D; const float* sc = sh + D;
            f32x4 v[4]; float ss = 0.f;
#pragma unroll
            for (int jq = 0; jq < 4; ++jq) { v[jq] = *(const f32x4*)(xr + 4 * lane + 256 * jq); ss += (v[jq][0] * v[jq][0] + v[jq][1] * v[jq][1]) + (v[jq][2] * v[jq][2] + v[jq][3] * v[jq][3]); }
            ss = wave_sum(ss); const float r = rsqrtf(ss * (1.f / D) + EPS);
#pragma unroll
            for (int jq = 0; jq < 4; ++jq) { const int col = 4 * lane + 256 * jq;
                const f32x4 o = v[jq] * r * *(const f32x4*)(n1g + col) * (*(const f32x4*)(sc + col) + 1.f) + *(const f32x4*)(sh + col);
                u32x2 w; w.x = cvt_pk_bf16(o[0], o[1]); w.y = cvt_pk_bf16(o[2], o[3]); *(u32x2*)(H + (size_t)row * D + col) = w; }
        }
    }
    SEAM(PH_NORM1);

    if (IN(PH_GEMM1)) {
        const EpiGemm1 Ep{AG, P};
        { pg8::PlainSched S; S.init(H, D, WIN, D, M, PCOLS, G, bx, 0); pg8::gemm_phase(lds, D, D, D, S, Ep); }
        { pg8::PlainSched S; S.init(H + (size_t)M * D, D, WIN, D, MC, SW, G, bx, 1); pg8::gemm_phase(lds, D, D, D, S, Ep); }
    }
    SEAM(PH_GEMM1);

    if (IN(PH_SSME)) {
        { pg8::BatchSched S; S.init(AG, AGK, (size_t)AGR * AGK * 2, WE, 1024, (size_t)256 * 1024 * 2, 5, 1, NG, G, bx); pg8::gemm_phase(lds, 1024, AGK, 1024, S, EpiE{E}); }
        {
            const int q = gt & 63; f32x4 w[3][2];
#pragma unroll
            for (int k = 0; k < 3; ++k) { w[k][0] = *(const f32x4*)(sconv_w + k * SW + q * 8); w[k][1] = *(const f32x4*)(sconv_w + k * SW + q * 8 + 4); }
            for (int m = gt >> 6; m < M; m += NGT >> 6) {
                const int t = m & 2047; f32x4 s0 = {0.f, 0.f, 0.f, 0.f}, s1 = {0.f, 0.f, 0.f, 0.f};
#pragma unroll
                for (int k = 0; k < 3; ++k) { const int tt = t + k - 1; if (tt < 0 || tt >= SEQ) continue; const bf16_t* pr = P + (size_t)(m + k - 1) * PW + q * 8;
                    f32x4 c0, c1, x0, x1; unpack8(*(const u32x4*)(pr + 512), c0, c1); unpack8(*(const u32x4*)(pr + 1024), x0, x1);
                    s0 += w[k][0] * (c0 * x0); s1 += w[k][1] * (c1 * x1); }
                f32x4 g0, g1; unpack8(*(const u32x4*)(P + (size_t)m * PW + q * 8), g0, g1);
                *(u32x4*)(YBR + (size_t)m * SW + q * 8) = pack8(g0 * s0, g1 * s1);
            }
        }
    }
    SEAM(PH_SSME);

    if (IN(PH_SCAN)) {
        for (int idx = gt; idx < NB * NG * 2 * PS; idx += NGT) {
            const int p = idx & 63, dir = (idx >> 6) & 1, g = (idx >> 7) & 31, b = idx >> 12;
            const f32x2 aT = APW[(((size_t)g * 2 + dir) * 65 + 64) * 64 + p];
            const float* Eg = E + (size_t)g * AGR * 256 + dir * 128 + p;
            bf16_t* Sg = AG + (size_t)g * AGR * AGK + 1024 + dir * 128 + p;
            float sr = 0.f, si = 0.f;
            for (int cc = 0; cc < NCC; ++cc) { const int c = dir ? NCC - 1 - cc : cc; const int row = NB * NCL + b * NCC + c;
                const float er = Eg[(size_t)row * 256], ei = Eg[(size_t)row * 256 + 64];
                const float nr = aT.x * sr - aT.y * si + er, ni = aT.x * si + aT.y * sr + ei; sr = nr; si = ni; }
            for (int cc = 0; cc < NCL; ++cc) { const int c = dir ? NCL - 1 - cc : cc; const int row = b * NCL + c;
                Sg[(size_t)row * AGK] = f2bf(sr); Sg[(size_t)row * AGK + 64] = f2bf(si);
                const float er = Eg[(size_t)row * 256], ei = Eg[(size_t)row * 256 + 64];
                const float nr = aT.x * sr - aT.y * si + er, ni = aT.x * si + aT.y * sr + ei; sr = nr; si = ni; }
        }
    }
    SEAM(PH_SCAN);

    if (IN(PH_SSMY)) {
        pg8::BatchSched S; S.init(AG, AGK, (size_t)AGR * AGK * 2, OP, AGK, (size_t)1024 * AGK * 2, 4, 4, NG, G, bx); pg8::gemm_phase(lds, AGK, AGK, AGK, S, EpiY{Z});
    }
    SEAM(PH_SSMY);

    if (IN(PH_GLU)) { pg8::PlainSched S; S.init(Z, SW, WGLU, SW, M, SW, G, bx, 0); pg8::gemm_phase(lds, SW, SW, SW, S, EpiGlu{Z, glu_b, YA}); }
    SEAM(PH_GLU);

    if (IN(PH_PROJ)) {
        { pg8::PlainSched S; S.init(YA, SW, WPA, SW, M, D, G, bx, 0); pg8::gemm_phase(lds, SW, SW, SW, S, EpiProj<false>{P, MG}); }
        { pg8::PlainSched S; S.init(YBR, SW, WPB, SW, M, D, G, bx, 0); pg8::gemm_phase(lds, SW, SW, SW, S, EpiProj<true>{P, MG}); }
    }
    SEAM(PH_PROJ);

    if (IN(PH_OUT)) { pg8::PlainSched S; S.init(MG, D, WOUT, D, M, D, G, bx, 0); pg8::gemm_phase(lds, D, D, D, S, EpiOut{x, MOD, n2g, out, X1S, SS1}); }
    SEAM(PH_OUT);

#define CONV_PHASE() do { \
        for (int item = bx; item < (HALF_ROWS / SEQ) * 11 * 8; item += G) { \
            const int cgp = item & 7, chg = (item >> 3) % 11, b = item / 88; \
            const int chunk = chg * 64 + lane, c = cgp * 8 + wave, ch = chunk * 4; \
            f32x4 wa[9], wv[9]; \
            _Pragma("unroll") for (int k = 0; k < 9; ++k) { wa[k] = *(const f32x4*)(conv_w + k * F2 + ch); wv[k] = *(const f32x4*)(conv_w + k * F2 + FH + ch); } \
            const bf16_t* base = UP + ((size_t)b * SEQ + c) * F2 + ch; \
            f32x4 A[3][3], V[3][3]; \
            _Pragma("unroll") for (int rr = 0; rr < 3; ++rr) _Pragma("unroll") for (int kx = 0; kx < 3; ++kx) { A[rr][kx] = (f32x4){0.f, 0.f, 0.f, 0.f}; V[rr][kx] = (f32x4){0.f, 0.f, 0.f, 0.f}; } \
            _Pragma("unroll") for (int kx = 0; kx < 3; ++kx) { const int cc = c + kx - 1; if (cc >= 0 && cc < 64) { const bf16_t* s = base + (ptrdiff_t)(kx - 1) * F2; \
                const u32x2 ua = *(const u32x2*)s, uv = *(const u32x2*)(s + FH); \
                A[2][kx] = (f32x4){__uint_as_float(ua.x << 16), __uint_as_float(ua.x & 0xffff0000u), __uint_as_float(ua.y << 16), __uint_as_float(ua.y & 0xffff0000u)}; \
                V[2][kx] = (f32x4){__uint_as_float(uv.x << 16), __uint_as_float(uv.x & 0xffff0000u), __uint_as_float(uv.y << 16), __uint_as_float(uv.y & 0xffff0000u)}; } } \
            for (int r = 0; r < 32; ++r) { \
                _Pragma("unroll") for (int kx = 0; kx < 3; ++kx) { A[0][kx] = A[1][kx]; A[1][kx] = A[2][kx]; V[0][kx] = V[1][kx]; V[1][kx] = V[2][kx]; A[2][kx] = (f32x4){0.f, 0.f, 0.f, 0.f}; V[2][kx] = (f32x4){0.f, 0.f, 0.f, 0.f}; } \
                if (r < 31) { _Pragma("unroll") for (int kx = 0; kx < 3; ++kx) { const int cc = c + kx - 1; if (cc >= 0 && cc < 64) { const bf16_t* s = base + ((ptrdiff_t)(r + 1) * 64 + (kx - 1)) * F2; \
                    const u32x2 ua = *(const u32x2*)s, uv = *(const u32x2*)(s + FH); \
                    A[2][kx] = (f32x4){__uint_as_float(ua.x << 16), __uint_as_float(ua.x & 0xffff0000u), __uint_as_float(ua.y << 16), __uint_as_float(ua.y & 0xffff0000u)}; \
                    V[2][kx] = (f32x4){__uint_as_float(uv.x << 16), __uint_as_float(uv.x & 0xffff0000u), __uint_as_float(uv.y << 16), __uint_as_float(uv.y & 0xffff0000u)}; } } } \
                f32x4 sa = {0.f, 0.f, 0.f, 0.f}, sv = {0.f, 0.f, 0.f, 0.f}; \
                _Pragma("unroll") for (int ky = 0; ky < 3; ++ky) _Pragma("unroll") for (int kx = 0; kx < 3; ++kx) { sa += wa[ky * 3 + kx] * A[ky][kx]; sv += wv[ky * 3 + kx] * V[ky][kx]; } \
                f32x4 o; _Pragma("unroll") for (int e = 0; e < 4; ++e) o[e] = sa[e] * fsig(sa[e]) * sv[e]; \
                u32x2 w; w.x = cvt_pk_bf16(o[0], o[1]); w.y = cvt_pk_bf16(o[2], o[3]); \
                *(u32x2*)(ACT + ((size_t)b * SEQ + r * 64 + c) * FH + ch) = w; \
            } \
        } } while (0)

    if (IN(PH_UP0)) { pg8::PlainSched S; S.init(X1S, D, WUP, D, HALF_ROWS, F2, G, bx, 0); pg8::gemm_phase(lds, D, D, D, S, EpiUp{SS1, BIASUP, UP, 0}); }
    SEAM(PH_UP0);
    if (IN(PH_CONV0)) CONV_PHASE();
    SEAM(PH_CONV0);
    if (IN(PH_DOWN0UP1)) {
        { pg8::PlainSched S; S.init(ACT, FH, WDOWN, FH, HALF_ROWS, D, G, bx, 0); pg8::gemm_phase(lds, FH, FH, FH, S, EpiDown{MOD, out, SS2, 0}); }
        { pg8::PlainSched S; S.init(X1S + (size_t)HALF_ROWS * D, D, WUP, D, HALF_ROWS, F2, G, bx, 0); pg8::gemm_phase(lds, D, D, D, S, EpiUp{SS1, BIASUP, UP, HALF_ROWS}); }
    }
    SEAM(PH_DOWN0UP1);
    if (IN(PH_CONV1)) CONV_PHASE();
    SEAM(PH_CONV1);
    if (IN(PH_DOWN1)) { pg8::PlainSched S; S.init(ACT, FH, WDOWN, FH, HALF_ROWS, D, G, bx, 0); pg8::gemm_phase(lds, FH, FH, FH, S, EpiDown{MOD, out, SS2, HALF_ROWS}); }
    SEAM(PH_DOWN1);

    if (IN(PH_FINAL)) {
        const int cq = gt & 255; const f32x4 fg = *(const f32x4*)(final_g + cq * 4);
        for (int row = gt >> 8; row < M; row += NGT >> 8) {
            const float rs = rsqrtf(SS2[row] * (1.f / D) + EPS); f32x4* p4 = (f32x4*)(out + (size_t)row * D + cq * 4); *p4 = *p4 * rs * fg; }
    }
}

extern "C" void kernel_launch(void* const* d_in, const int* in_sizes, int n_in, void* d_out, int out_size, void* d_ws, size_t ws_size, hipStream_t stream) {
    static int grid = 0;
    if (grid == 0) {
        if (n_in != 27 || ws_size < WS_NEED || out_size != M * D) { fprintf(stderr, "kernel_launch: bad args n_in=%d ws=%zu out=%d\n", n_in, ws_size, out_size); grid = -1; return; }
        int dev = 0, cus = 0, per_cu = 0;
        if (hipGetDevice(&dev) != hipSuccess || hipDeviceGetAttribute(&cus, hipDeviceAttributeMultiprocessorCount, dev) != hipSuccess) { grid = -1; return; }
        if (hipFuncSetAttribute((const void*)mega, hipFuncAttributeMaxDynamicSharedMemorySize, LDS_BYTES) != hipSuccess) { fprintf(stderr, "kernel_launch: hipFuncSetAttribute failed\n"); grid = -1; return; }
        if (hipOccupancyMaxActiveBlocksPerMultiprocessor(&per_cu, (const void*)mega, NTHREADS, LDS_BYTES) != hipSuccess || per_cu < 1) { fprintf(stderr, "kernel_launch: occupancy query says %d\n", per_cu); (void)hipGetLastError(); grid = -1; return; }
        grid = cus;
        if (grid % 8 != 0) { fprintf(stderr, "kernel_launch: CU count %d not a multiple of 8\n", grid); grid = -1; return; }
    }
    if (grid < 0) return;
    const float* x = (const float*)d_in[0]; const float* c = (const float*)d_in[1]; const float* ctx = (const float*)d_in[2]; const float* c_ctx = (const float*)d_in[3];
    const float* mod_w = (const float*)d_in[4]; const float* mod_b = (const float*)d_in[5]; const float* n1g = (const float*)d_in[6]; const float* n2g = (const float*)d_in[7];
    const float* w_in = (const float*)d_in[8]; const float* lam_re = (const float*)d_in[9]; const float* lam_im = (const float*)d_in[10]; const float* log_dt = (const float*)d_in[11];
    const float* b_re = (const float*)d_in[12]; const float* b_im = (const float*)d_in[13]; const float* c_re = (const float*)d_in[14]; const float* c_im = (const float*)d_in[15];
    const float* ssm_d = (const float*)d_in[16]; const float* glu_w = (const float*)d_in[17]; const float* glu_b = (const float*)d_in[18]; const float* sconv_w = (const float*)d_in[19];
    const float* proj_a = (const float*)d_in[20]; const float* proj_b = (const float*)d_in[21]; const float* w_out = (const float*)d_in[22]; const float* w_up = (const float*)d_in[23];
    const float* conv_w = (const float*)d_in[24]; const float* w_down = (const float*)d_in[25]; const float* final_g = (const float*)d_in[26];
    unsigned char* ws = (unsigned char*)d_ws; float* out = (float*)d_out;
    float* MOD = (float*)(ws + WS_MOD); float* BIASUP = (float*)(ws + WS_BIASUP); float* SS1 = (float*)(ws + WS_SS1); float* SS2 = (float*)(ws + WS_SS2);
    bf16_t* P = (bf16_t*)(ws + WS_P); bf16_t* H = (bf16_t*)(ws + WS_H); bf16_t* AG = (bf16_t*)(ws + WS_AG);
    bf16_t* YBR = (bf16_t*)(ws + WS_YBR); bf16_t* Z = (bf16_t*)(ws + WS_Z); bf16_t* YA = (bf16_t*)(ws + WS_YA); bf16_t* MG = (bf16_t*)(ws + WS_MERGED);
    bf16_t* X1S = (bf16_t*)(ws + WS_X1S); bf16_t* UP = (bf16_t*)(ws + WS_UP); bf16_t* ACT = (bf16_t*)(ws + WS_ACT);
    float* YF = (float*)(ws + WS_H);

    (void)hipMemsetAsync(ws + WS_CTL, 0, CTL_ZERO_BYTES, stream);
    Args a{};
    for (int i = 0; i < 27; ++i) a.in[i] = (const float*)d_in[i];
    a.out = out; a.ws = ws;
#define RUN(lo_, hi_) do { a.ph_lo = (lo_); a.ph_hi = (hi_); hipLaunchKernelGGL(mega, dim3(grid), dim3(NTHREADS), LDS_BYTES, stream, a); } while (0)
#define OPT(p) ((OPT_MASK >> (p)) & 1)
#if MK_ONE_LAUNCH
    a.ph_lo = 0; a.ph_hi = PH_COUNT;
    void* kargs[] = {&a};
    hipError_t e = hipLaunchCooperativeKernel((const void*)mega, dim3(grid), dim3(NTHREADS), kargs, LDS_BYTES, stream);
    if (e != hipSuccess) fprintf(stderr, "kernel_launch: cooperative launch failed: %s\n", hipGetErrorString(e));
#else
    if (OPT(0)) RUN(PH_PRO, PH_PRO + 1); else k_mod<<<dim3(6 * D / 256, NB + 1), 256, 0, stream>>>(c, c_ctx, mod_w, mod_b, MOD);
    if (OPT(1)) RUN(PH_NORM1, PH_NORM1 + 1);
    else { k_norm1<<<(M + MC) / 4, 256, 0, stream>>>(x, ctx, n1g, MOD, H); k_biasup<<<dim3(F2 / 256, NB), 256, 0, stream>>>(MOD, w_up, BIASUP); }
    if (OPT(2)) RUN(PH_GEMM1, PH_GEMM1 + 1);
    else { k_gemm<EpiIn><<<dim3(PCOLS / 64, M / 64), 256, 0, stream>>>(H, D, w_in, PCOLS, D, EpiIn{AG, P});
           k_gemm<EpiInCtx><<<dim3(SW / 64, MC / 64), 256, 0, stream>>>(H + (size_t)M * D, D, w_in, PCOLS, D, EpiInCtx{AG}); }
    if (OPT(3)) { RUN(PH_SSME, PH_SSME + 1); RUN(PH_SCAN, PH_SCAN + 1); RUN(PH_SSMY, PH_SSMY + 1); }
    else { k_ybr<<<(unsigned)(((size_t)M * SW + 255) / 256), 256, 0, stream>>>(P, sconv_w, YBR);
           k_ssm<<<dim3(NB, NG), 64, 0, stream>>>(AG, lam_re, lam_im, log_dt, b_re, b_im, c_re, c_im, ssm_d, YF, Z); }
    if (OPT(4)) RUN(PH_GLU, PH_GLU + 1); else k_gemm<EpiGluN><<<dim3(SW / 64, M / 64), 256, 0, stream>>>(Z, SW, glu_w, SW, SW, EpiGluN{Z, glu_b, YA});
    if (OPT(5)) RUN(PH_PROJ, PH_PROJ + 1);
    else { k_gemm<EpiProjAN><<<dim3(D / 64, M / 64), 256, 0, stream>>>(YA, SW, proj_a, D, SW, EpiProjAN{P, MG});
           k_gemm<EpiProjBN><<<dim3(D / 64, M / 64), 256, 0, stream>>>(YBR, SW, proj_b, D, SW, EpiProjBN{P, MG}); }
    if (OPT(6)) RUN(PH_OUT, PH_OUT + 1);
    else { k_gemm<EpiOutN><<<dim3(D / 64, M / 64), 256, 0, stream>>>(MG, D, w_out, D, D, EpiOutN{x, MOD, n2g, out, X1S}); k_rowss<<<M / 4, 256, 0, stream>>>(out, SS1); }
    if (OPT(7)) { RUN(PH_UP0, PH_UP0 + 1); RUN(PH_CONV0, PH_CONV0 + 1); RUN(PH_DOWN0UP1, PH_DOWN0UP1 + 1); RUN(PH_CONV1, PH_CONV1 + 1); RUN(PH_DOWN1, PH_DOWN1 + 1); RUN(PH_FINAL, PH_FINAL + 1); }
    else {
        for (int half = 0; half < 2; ++half) { const int row0 = half * HALF_ROWS;
            k_gemm<EpiUpN><<<dim3(F2 / 64, HALF_ROWS / 64), 256, 0, stream>>>(X1S + (size_t)row0 * D, D, w_up, F2, D, EpiUpN{SS1, BIASUP, UP, row0, 0});
            k_conv<<<(unsigned)(((size_t)HALF_ROWS * FH + 255) / 256), 256, 0, stream>>>(UP, conv_w, ACT);
            k_gemm<EpiDownN><<<dim3(D / 64, HALF_ROWS / 64), 256, 0, stream>>>(ACT, FH, w_down, D, FH, EpiDownN{MOD, out, row0, 0}); }
        k_final<<<M / 4, 256, 0, stream>>>(out, final_g);
    }
#endif
}
```

```cpp
#include <hip/hip_runtime.h>
#include <hip/hip_cooperative_groups.h>
#include <stdint.h>
#include <cstdio>
namespace cg = cooperative_groups;

#ifndef MK_ONE_LAUNCH
#define MK_ONE_LAUNCH 1
#endif
#ifndef PROBE_DUP
#define PROBE_DUP 0x0
#endif
#ifndef OPT_MASK
#define OPT_MASK 0xFF
#endif

typedef unsigned short bf16_t;
typedef float f32x4 __attribute__((ext_vector_type(4)));
typedef float f32x2 __attribute__((ext_vector_type(2)));
typedef unsigned u32x4 __attribute__((ext_vector_type(4)));
typedef unsigned u32x2 __attribute__((ext_vector_type(2)));
typedef short bf16x8 __attribute__((ext_vector_type(8)));
#define LAS __attribute__((address_space(3)))

constexpr int D = 1024, NB = 32, SEQ = 2048, CTXL = 256;
constexpr int M = NB * SEQ;
constexpr int MC = NB * CTXL;
constexpr int PCOLS = 4096, SW = 512, NG = 32, GH = 16, PS = 64;
constexpr int FH = 2816, F2 = 5632;
constexpr int TCH = 64;
constexpr int NCL = SEQ / TCH;
constexpr int NCC = CTXL / TCH;
constexpr int AGK = TCH * GH + 4 * PS;
constexpr int AGR = NB * NCL + NB * NCC;
constexpr int PW = PCOLS - SW;
constexpr int HALF_ROWS = M / 2;
constexpr float EPS = 1e-6f;

constexpr size_t MiB = 1ull << 20;
constexpr size_t WS_CTL = 0;
constexpr size_t WS_ZEROS = 32 * 1024;
constexpr size_t WS_YBRCNT = 33 * 1024;
constexpr size_t WS_MOD = 64 * 1024;
constexpr size_t WS_BIASUP = 1 * MiB;
constexpr size_t WS_SS1 = 2 * MiB;
constexpr size_t WS_SS2 = 2 * MiB + 256 * 1024;
constexpr size_t CTL_ZERO_BYTES = 3 * MiB;
constexpr size_t WS_WIN = 4 * MiB;
constexpr size_t WS_WGLU = 12 * MiB;
constexpr size_t WS_WPA = 13 * MiB;
constexpr size_t WS_WPB = 14 * MiB;
constexpr size_t WS_WOUT = 15 * MiB;
constexpr size_t WS_WUP = 17 * MiB;
constexpr size_t WS_WDOWN = 28 * MiB;
constexpr size_t WS_OP = 34 * MiB;
constexpr size_t WS_WE = 114 * MiB;
constexpr size_t WS_P = 130 * MiB;
constexpr size_t WS_H = 578 * MiB;
constexpr size_t WS_AG = 722 * MiB;
constexpr size_t WS_E = 812 * MiB;
constexpr size_t WS_YBR = 850 * MiB;
constexpr size_t WS_Z = 914 * MiB;
constexpr size_t WS_YA = 578 * MiB;
constexpr size_t WS_MERGED = 722 * MiB;
constexpr size_t WS_X1S = 130 * MiB;
constexpr size_t WS_UP = 258 * MiB;
constexpr size_t WS_ACT = 610 * MiB;
constexpr size_t WS_KT = 1016 * MiB;
constexpr size_t WS_APW = 1020 * MiB;
constexpr size_t WS_NEED = 1024 * MiB;

__device__ __forceinline__ float bf2f(bf16_t v) { return __uint_as_float(((unsigned)v) << 16); }
__device__ __forceinline__ bf16_t f2bf(float f) { unsigned u = __float_as_uint(f); return (bf16_t)((u + 0x7fffu + ((u >> 16) & 1u)) >> 16); }
__device__ __forceinline__ float sigmoidf_(float x) { return 1.f / (1.f + __expf(-x)); }
__device__ __forceinline__ float siluf_(float x) { return x * sigmoidf_(x); }
__device__ __forceinline__ float gelu_tanh(float x) { const float k = 0.7978845608028654f; return 0.5f * x * (1.f + tanhf(k * (x + 0.044715f * x * x * x))); }
__device__ __forceinline__ float wave_sum(float v) {
#pragma unroll
    for (int o = 1; o < 64; o <<= 1) v += __shfl_xor(v, o);
    return v;
}
__device__ __forceinline__ float fsig(float x) { return __builtin_amdgcn_rcpf(1.f + __builtin_amdgcn_exp2f(-1.4426950408889634f * x)); }
__device__ __forceinline__ float fgelu(float x) { const float y = 1.5957691216057308f * (x + 0.044715f * x * x * x); return x * fsig(y); }
__device__ __forceinline__ unsigned cvt_pk_bf16(float lo, float hi) { unsigned r; asm volatile("v_cvt_pk_bf16_f32 %0, %1, %2" : "=v"(r) : "v"(lo), "v"(hi)); return r; }
__device__ __forceinline__ u32x4 pack8(const f32x4 a, const f32x4 b) { u32x4 w; w.x = cvt_pk_bf16(a[0], a[1]); w.y = cvt_pk_bf16(a[2], a[3]); w.z = cvt_pk_bf16(b[0], b[1]); w.w = cvt_pk_bf16(b[2], b[3]); return w; }
__device__ __forceinline__ void unpack8(const u32x4 w, f32x4& a, f32x4& b) {
    a[0] = __uint_as_float(w.x << 16); a[1] = __uint_as_float(w.x & 0xffff0000u); a[2] = __uint_as_float(w.y << 16); a[3] = __uint_as_float(w.y & 0xffff0000u);
    b[0] = __uint_as_float(w.z << 16); b[1] = __uint_as_float(w.z & 0xffff0000u); b[2] = __uint_as_float(w.w << 16); b[3] = __uint_as_float(w.w & 0xffff0000u); }

__device__ __forceinline__ void ssm_disc(float lr, float li, float dt, float& ar, float& ai, float& qr, float& qi) {
    const float ex = expf(lr * dt); float sn, cs; sincosf(li * dt, &sn, &cs);
    ar = ex * cs; ai = ex * sn;
    float sh, chh; sincosf(0.5f * li * dt, &sh, &chh);
    const float xr = expm1f(lr * dt) * cs - 2.f * sh * sh, xi = ex * sn;
    const float den = lr * lr + li * li;
    qr = (xr * lr + xi * li) / den; qi = (xi * lr - xr * li) / den;
}
__device__ __forceinline__ void ssm_apow(float lr, float li, float dt, float k, float& pr, float& pi) {
    const float ex = expf(lr * dt * k); float sn, cs; sincosf(li * dt * k, &sn, &cs); pr = ex * cs; pi = ex * sn;
}

__global__ void k_mod(const float* c, const float* c_ctx, const float* mod_w, const float* mod_b, float* MOD) {
    int n = blockIdx.x * blockDim.x + threadIdx.x; int r = blockIdx.y;
    if (n >= 6 * D) return;
    const float* cond = r < NB ? c + (size_t)r * D : c_ctx;
    float acc = 0.f;
    for (int k = 0; k < D; ++k) acc += siluf_(cond[k]) * mod_w[(size_t)k * 6 * D + n];
    MOD[(size_t)r * 6 * D + n] = acc + mod_b[n];
}
__global__ void k_norm1(const float* x, const float* ctx, const float* g, const float* MOD, bf16_t* H) {
    int row = blockIdx.x * (blockDim.x / 64) + (threadIdx.x >> 6); int lane = threadIdx.x & 63;
    if (row >= M + MC) return;
    const float* xr; int mr;
    if (row < M) { xr = x + (size_t)row * D; mr = row / SEQ; } else { xr = ctx + (size_t)(row - M) * D; mr = NB; }
    const float* sh = MOD + (size_t)mr * 6 * D; const float* sc = sh + D;
    float ss = 0.f;
    for (int k = lane; k < D; k += 64) { float v = xr[k]; ss += v * v; }
    ss = wave_sum(ss);
    float r = rsqrtf(ss / D + EPS);
    for (int k = lane; k < D; k += 64) H[(size_t)row * D + k] = f2bf(xr[k] * r * g[k] * (1.f + sc[k]) + sh[k]);
}
template <class Epi>
__global__ void __launch_bounds__(256) k_gemm(const bf16_t* A, int lda, const float* W, int ldw, int K, Epi epi) {
    __shared__ float As[16][65];
    __shared__ float Ws[16][64];
    const int tx = threadIdx.x & 15, ty = threadIdx.x >> 4;
    const int m0 = blockIdx.y * 64, n0 = blockIdx.x * 64;
    float acc[4][4];
#pragma unroll
    for (int i = 0; i < 4; ++i)
#pragma unroll
        for (int j = 0; j < 4; ++j) acc[i][j] = 0.f;
    for (int k0 = 0; k0 < K; k0 += 16) {
#pragma unroll
        for (int i = 0; i < 4; ++i) { int idx = threadIdx.x + i * 256; int r = idx >> 4, kk = idx & 15; As[kk][r] = bf2f(A[(size_t)(m0 + r) * lda + k0 + kk]); }
#pragma unroll
        for (int i = 0; i < 4; ++i) { int idx = threadIdx.x + i * 256; int kk = idx >> 6, cc = idx & 63; Ws[kk][cc] = W[(size_t)(k0 + kk) * ldw + n0 + cc]; }
        __syncthreads();
#pragma unroll
        for (int kk = 0; kk < 16; ++kk) {
            float a[4], b[4];
#pragma unroll
            for (int i = 0; i < 4; ++i) a[i] = As[kk][ty * 4 + i];
#pragma unroll
            for (int j = 0; j < 4; ++j) b[j] = Ws[kk][tx * 4 + j];
#pragma unroll
            for (int i = 0; i < 4; ++i)
#pragma unroll
                for (int j = 0; j < 4; ++j) acc[i][j] += a[i] * b[j];
        }
        __syncthreads();
    }
#pragma unroll
    for (int i = 0; i < 4; ++i)
#pragma unroll
        for (int j = 0; j < 4; ++j) epi(m0 + ty * 4 + i, n0 + tx * 4 + j, acc[i][j]);
}
struct EpiIn {
    bf16_t* AG; bf16_t* P;
    __device__ void operator()(int m, int n, float v) const {
        if (n < SW) { int b = m / SEQ, t = m % SEQ, g = n / GH, h = n % GH;
            AG[((size_t)g * AGR + b * NCL + t / TCH) * AGK + (t % TCH) * GH + h] = f2bf(v); }
        else P[(size_t)m * PW + (n - SW)] = f2bf(n >= 2048 ? sigmoidf_(v) : v);
    }
};
struct EpiInCtx {
    bf16_t* AG;
    __device__ void operator()(int m, int n, float v) const {
        int b = m / CTXL, t = m % CTXL, g = n / GH, h = n % GH;
        AG[((size_t)g * AGR + NB * NCL + b * NCC + t / TCH) * AGK + (t % TCH) * GH + h] = f2bf(v);
    }
};
struct EpiGluN { const bf16_t* Z; const float* bias; bf16_t* YA;
    __device__ void operator()(int m, int n, float v) const { float z = bf2f(Z[(size_t)m * SW + n]); YA[(size_t)m * SW + n] = f2bf(z * sigmoidf_(v + bias[n])); } };
struct EpiProjAN { const bf16_t* P; bf16_t* MG;
    __device__ void operator()(int m, int n, float v) const { float ga = bf2f(P[(size_t)m * PW + 1536 + n]); MG[(size_t)m * D + n] = f2bf(ga * v); } };
struct EpiProjBN { const bf16_t* P; bf16_t* MG;
    __device__ void operator()(int m, int n, float v) const { float gb = bf2f(P[(size_t)m * PW + 2560 + n]); MG[(size_t)m * D + n] = f2bf(bf2f(MG[(size_t)m * D + n]) + gb * v); } };
struct EpiOutN { const float* x; const float* MOD; const float* n2g; float* X1; bf16_t* X1S;
    __device__ void operator()(int m, int n, float v) const { int b = m / SEQ; const float* md = MOD + (size_t)b * 6 * D;
        float x1 = x[(size_t)m * D + n] + md[2 * D + n] * v; X1[(size_t)m * D + n] = x1;
        X1S[(size_t)m * D + n] = f2bf(x1 * n2g[n] * (1.f + md[4 * D + n])); } };
struct EpiUpN { const float* SS1; const float* BIASUP; bf16_t* UP; int row0; int pad;
    __device__ void operator()(int m, int n, float v) const { int mg = row0 + m; int b = mg / SEQ;
        float r = rsqrtf(SS1[mg] / D + EPS); UP[(size_t)m * F2 + n] = f2bf(v * r + BIASUP[(size_t)b * F2 + n]); } };
struct EpiDownN { const float* MOD; float* X; int row0; int pad;
    __device__ void operator()(int m, int n, float v) const { int mg = row0 + m; int b = mg / SEQ;
        X[(size_t)mg * D + n] += MOD[(size_t)b * 6 * D + 5 * D + n] * v; } };

__global__ void __launch_bounds__(64) k_ssm(const bf16_t* AG, const float* lam_re, const float* lam_im, const float* log_dt,
                                           const float* b_re, const float* b_im, const float* c_re, const float* c_im, const float* dsk,
                                           float* YF, bf16_t* Z) {
    const int b = blockIdx.x, g = blockIdx.y, p = threadIdx.x;
    float* yf = YF + ((size_t)(b * NG + g) * SEQ) * GH;
    for (int dir = 0; dir < 2; ++dir) {
        const float lr = lam_re[(dir * NG + g) * PS + p], li = lam_im[(dir * NG + g) * PS + p];
        const float dt = expf(log_dt[dir * NG + g]);
        float ar, ai, qr, qi; ssm_disc(lr, li, dt, ar, ai, qr, qi);
        float br[GH], bi[GH], cr[GH], ci[GH];
#pragma unroll
        for (int h = 0; h < GH; ++h) {
            const float tr = b_re[(((size_t)dir * NG + g) * PS + p) * GH + h], ti = b_im[(((size_t)dir * NG + g) * PS + p) * GH + h];
            br[h] = qr * tr - qi * ti; bi[h] = qr * ti + qi * tr;
            cr[h] = c_re[(((size_t)dir * NG + g) * GH + h) * PS + p]; ci[h] = c_im[(((size_t)dir * NG + g) * GH + h) * PS + p];
        }
        float sr = 0.f, si = 0.f;
        for (int n = 0; n < CTXL + SEQ; ++n) {
            const bf16_t* up; int t = 0; bool lat;
            if (n < CTXL) { int j = dir == 0 ? n : CTXL - 1 - n; lat = false;
                up = AG + ((size_t)g * AGR + NB * NCL + b * NCC + j / TCH) * AGK + (j % TCH) * GH; }
            else { t = dir == 0 ? n - CTXL : SEQ - 1 - (n - CTXL); lat = true;
                up = AG + ((size_t)g * AGR + b * NCL + t / TCH) * AGK + (t % TCH) * GH; }
            float u[GH];
#pragma unroll
            for (int h = 0; h < GH; ++h) u[h] = bf2f(up[h]);
            float bur = 0.f, bui = 0.f;
#pragma unroll
            for (int h = 0; h < GH; ++h) { bur += br[h] * u[h]; bui += bi[h] * u[h]; }
            const float nr = ar * sr - ai * si + bur, ni = ar * si + ai * sr + bui; sr = nr; si = ni;
            if (lat) {
                float mine = 0.f;
#pragma unroll
                for (int h = 0; h < GH; ++h) { float v = wave_sum(cr[h] * sr - ci[h] * si); if (p == h) mine = v; }
                if (p < GH) {
                    if (dir == 0) yf[(size_t)t * GH + p] = mine;
                    else { float uu = 0.f;
#pragma unroll
                        for (int h = 0; h < GH; ++h) if (p == h) uu = u[h];
                        float y = dsk[g * GH + p] * uu + yf[(size_t)t * GH + p] + mine;
                        Z[((size_t)b * SEQ + t) * SW + g * GH + p] = f2bf(gelu_tanh(y)); }
                }
            }
        }
    }
}
__global__ void k_ybr(const bf16_t* P, const float* sw, bf16_t* YBR) {
    size_t idx = (size_t)blockIdx.x * blockDim.x + threadIdx.x; if (idx >= (size_t)M * SW) return;
    int m = (int)(idx / SW), ch = (int)(idx % SW); int t = m % SEQ;
    float acc = 0.f;
#pragma unroll
    for (int k = 0; k < 3; ++k) { int tt = t + k - 1; if (tt < 0 || tt >= SEQ) continue; size_t mm = (size_t)(m + k - 1);
        acc += sw[k * SW + ch] * bf2f(P[mm * PW + 512 + ch]) * bf2f(P[mm * PW + 1024 + ch]); }
    YBR[idx] = f2bf(bf2f(P[(size_t)m * PW + ch]) * acc);
}
__global__ void k_rowss(const float* X, float* SS) {
    int row = blockIdx.x * (blockDim.x / 64) + (threadIdx.x >> 6); int lane = threadIdx.x & 63; if (row >= M) return;
    float ss = 0.f; for (int k = lane; k < D; k += 64) { float v = X[(size_t)row * D + k]; ss += v * v; }
    ss = wave_sum(ss); if (lane == 0) SS[row] = ss;
}
__global__ void k_biasup(const float* MOD, const float* wup, float* BIASUP) {
    int n = blockIdx.x * blockDim.x + threadIdx.x; int b = blockIdx.y; if (n >= F2) return;
    const float* sh2 = MOD + (size_t)b * 6 * D + 3 * D; float acc = 0.f;
    for (int k = 0; k < D; ++k) acc += sh2[k] * wup[(size_t)k * F2 + n];
    BIASUP[(size_t)b * F2 + n] = acc;
}
__global__ void k_conv(const bf16_t* UP, const float* cw, bf16_t* ACT) {
    size_t idx = (size_t)blockIdx.x * blockDim.x + threadIdx.x; if (idx >= (size_t)HALF_ROWS * FH) return;
    int m = (int)(idx / FH), j = (int)(idx % FH); int t = m % SEQ; int r = t / 64, c = t % 64;
    float a = 0.f, v = 0.f;
#pragma unroll
    for (int ky = 0; ky < 3; ++ky)
#pragma unroll
        for (int kx = 0; kx < 3; ++kx) { int rr = r + ky - 1, cc = c + kx - 1; if (rr < 0 || rr >= 32 || cc < 0 || cc >= 64) continue;
            size_t mm = (size_t)(m + (ky - 1) * 64 + (kx - 1));
            a += cw[(ky * 3 + kx) * F2 + j] * bf2f(UP[mm * F2 + j]); v += cw[(ky * 3 + kx) * F2 + FH + j] * bf2f(UP[mm * F2 + FH + j]); }
    ACT[idx] = f2bf(siluf_(a) * v);
}
__global__ void k_final(float* X, const float* fg) {
    int row = blockIdx.x * (blockDim.x / 64) + (threadIdx.x >> 6); int lane = threadIdx.x & 63; if (row >= M) return;
    float* xr = X + (size_t)row * D; float ss = 0.f;
    for (int k = lane; k < D; k += 64) { float v = xr[k]; ss += v * v; }
    ss = wave_sum(ss); float r = rsqrtf(ss / D + EPS);
    for (int k = lane; k < D; k += 64) xr[k] = xr[k] * r * fg[k];
}

namespace pg8 {
constexpr int BM = 256, BK = 64, HALF = 128, HTB = HALF * BK * 2, STAGE_BYTES = 8 * HTB, NXCD = 8, WGM = 8;
__host__ __device__ __forceinline__ int lds_byte(int r, int c) { const int st = (r >> 4) * 2 + (c >> 5), rr = r & 15, cc = c & 31, ob = rr * 64 + cc * 2; return st * 1024 + (ob ^ (((ob >> 9) & 1) << 5)); }
__host__ __device__ __forceinline__ void stage_rc(int b, int& R, int& C) { const int st = b / 1024, sb = b % 1024, swz = sb ^ (((sb >> 9) & 1) << 5); R = (st >> 1) * 16 + swz / 64; C = (st & 1) * 32 + (swz % 64) / 2; }
__host__ __device__ __forceinline__ int perm32(int rho) { const int n = rho >> 4, i = rho & 15; return 8 * (i >> 2) + 4 * n + (i & 3); }

struct Unit { const char* A; const char* B; int pm, pn, z; };

struct PlainSched {
    const char* A; const char* B; size_t a_tile, b_tile; int nM, nN, nwg, G, c, z, reps = 1;
    __device__ void init(const void* A_, int lda, const void* B_, int ldb, int Mr, int N, int G_, int c_, int z_) {
        A = (const char*)A_; B = (const char*)B_; a_tile = (size_t)BM * lda * 2; b_tile = (size_t)BM * ldb * 2; nM = Mr / BM; nN = N / BM; nwg = nM * nN; G = G_; c = c_; z = z_; }
    __device__ bool next(int i, Unit& u) const {
        long L = (long)i * G + c; if (L >= (long)nwg * reps) return false; L %= nwg;
        int wgid = (int)L; { const int q = nwg / NXCD, r = nwg % NXCD, xcd = wgid % NXCD, off = wgid / NXCD; wgid = (xcd < r ? xcd * (q + 1) : r * (q + 1) + (xcd - r) * q) + off; }
        const int nig = WGM * nN, gid = wgid / nig, fm = gid * WGM, gsz = (nM - fm) < WGM ? (nM - fm) : WGM;
        u.pm = fm + ((wgid % nig) % gsz); u.pn = (wgid % nig) / gsz; u.z = z;
        u.A = A + (size_t)u.pm * a_tile; u.B = B + (size_t)u.pn * b_tile; return true;
    }
};
struct BatchSched {
    const char* A; const char* B; size_t a_tile, b_tile, a_z, b_z; int nM, nN, per_z, zpx, gpx, x, j;
    __device__ void init(const void* A_, int lda, size_t a_z_, const void* B_, int ldb, size_t b_z_, int nM_, int nN_, int nZ, int G, int c) {
        A = (const char*)A_; B = (const char*)B_; a_tile = (size_t)BM * lda * 2; b_tile = (size_t)BM * ldb * 2; a_z = a_z_; b_z = b_z_;
        nM = nM_; nN = nN_; per_z = nM_ * nN_; zpx = nZ / NXCD; gpx = G / NXCD; x = c % NXCD; j = c / NXCD; }
    __device__ bool next(int i, Unit& u) const {
        const int q = i * gpx + j; if (j >= gpx || q >= zpx * per_z) return false;
        const int z = x * zpx + q / per_z, r = q % per_z; u.pm = r % nM; u.pn = r / nM; u.z = z;
        u.A = A + (size_t)z * a_z + (size_t)u.pm * a_tile; u.B = B + (size_t)z * b_z + (size_t)u.pn * b_tile; return true;
    }
};

template <class Epi, class Sched>
__device__ __forceinline__ void gemm_phase(LAS unsigned char* lds, const int K, const int lda, const int ldb, const Sched& S, const Epi& E) {
    const int tid = threadIdx.x, wid = __builtin_amdgcn_readfirstlane(tid >> 6), lane = tid & 63, wr = wid >> 2, wc = wid & 3, fr = lane & 15, fq = lane >> 4;
    const int nt = K / BK;
    unsigned voffA[2], voffB[2];
#pragma unroll
    for (int i = 0; i < 2; ++i) { int R, C; stage_rc(tid * 16 + i * 8192, R, C); const int Rb = Epi::PERM ? ((R & ~31) + perm32(R & 31)) : R;
        voffA[i] = (unsigned)(R * lda + C) * 2u; voffB[i] = (unsigned)(Rb * ldb + C) * 2u; }
    const size_t kstep = (size_t)(BK * 2);
    const size_t hstepA = (size_t)HALF * lda * 2, hstepB = (size_t)HALF * ldb * 2;
    const unsigned ldsw = (unsigned)wid * 1024u;
    const int aoff = lds_byte(wr * 64 + fr, fq * 8), boff = lds_byte(wc * 32 + fr, fq * 8);
#define PG8_SA(b, h) (((b) * 2 + (h)) * HTB)
#define PG8_SB(b, h) ((4 + (b) * 2 + (h)) * HTB)
#define PG8_STAGE(bufoff, gbase, voff) do { _Pragma("unroll") for (int _i = 0; _i < 2; ++_i) \
        __builtin_amdgcn_global_load_lds((const unsigned*)((const char*)(gbase) + (voff)[_i]), (LAS unsigned*)(lds + (bufoff) + ldsw + _i * 8192), 16, 0, 0); } while (0)
#define PG8_LDA(dst, b, h) do { _Pragma("unroll") for (int m = 0; m < 4; ++m) _Pragma("unroll") for (int k = 0; k < 2; ++k) dst[m][k] = *(const LAS bf16x8*)(lds + PG8_SA(b, h) + aoff + m * 2048 + k * 1024); } while (0)
#define PG8_LDB(dst, b, h) do { _Pragma("unroll") for (int n = 0; n < 2; ++n) _Pragma("unroll") for (int k = 0; k < 2; ++k) dst[n][k] = *(const LAS bf16x8*)(lds + PG8_SB(b, h) + boff + n * 2048 + k * 1024); } while (0)
#define PG8_MMA(ai, bj, At, Bt) do { __builtin_amdgcn_s_setprio(1); _Pragma("unroll") for (int m = 0; m < 4; ++m) _Pragma("unroll") for (int n = 0; n < 2; ++n) _Pragma("unroll") for (int k = 0; k < 2; ++k) \
        acc[ai][bj][m][n] = __builtin_amdgcn_mfma_f32_16x16x32_bf16(Bt[n][k], At[m][k], acc[ai][bj][m][n], 0, 0, 0); __builtin_amdgcn_s_setprio(0); } while (0)
#define PG8_WAIT_V(n) asm volatile("s_waitcnt vmcnt(" #n ")" ::: "memory")
#define PG8_WAIT_L(n) asm volatile("s_waitcnt lgkmcnt(" #n ")" ::: "memory")
#define PG8_BAR __builtin_amdgcn_s_barrier()
#define PG8_SCHED __builtin_amdgcn_sched_barrier(0)
    Unit cur, nxt; int ui = 0;
    if (!S.next(0, cur)) return;
    f32x4 acc[2][2][4][2];
#pragma unroll
    for (int a = 0; a < 2; ++a)
#pragma unroll
        for (int b = 0; b < 2; ++b)
#pragma unroll
            for (int m = 0; m < 4; ++m)
#pragma unroll
                for (int n = 0; n < 2; ++n) acc[a][b][m][n] = (f32x4){0.f, 0.f, 0.f, 0.f};
    bf16x8 At[4][2], B0[2][2], B1[2][2];
    const char* cA = cur.A; const char* cB = cur.B;
    PG8_STAGE(PG8_SB(0, 0), cB, voffB); PG8_STAGE(PG8_SB(0, 1), cB + hstepB, voffB); PG8_STAGE(PG8_SA(0, 0), cA, voffA); PG8_STAGE(PG8_SA(0, 1), cA + hstepA, voffA);
    if (wr == 1) PG8_BAR;
    PG8_WAIT_V(2); PG8_BAR;
    PG8_STAGE(PG8_SB(1, 0), cB + kstep, voffB); PG8_STAGE(PG8_SA(1, 0), cA + kstep, voffA); PG8_STAGE(PG8_SB(1, 1), cB + hstepB + kstep, voffB);
    PG8_WAIT_V(6); PG8_BAR;
    for (;;) {
        const bool has_next = S.next(ui + 1, nxt);
        const char* nA = has_next ? nxt.A : cA; const char* nB = has_next ? nxt.B : cB;
        for (int t = 0; t < nt; t += 2) {
            const bool last = (t == nt - 2);
            const char* a1 = cA + (size_t)(t + 1) * kstep;
            const char* a2 = last ? nA : cA + (size_t)(t + 2) * kstep; const char* b2 = last ? nB : cB + (size_t)(t + 2) * kstep;
            const char* a3 = a2 + kstep; const char* b3 = b2 + kstep;
            PG8_LDB(B0, 0, 0); PG8_LDB(B1, 0, 1); PG8_SCHED; PG8_LDA(At, 0, 0); PG8_STAGE(PG8_SA(1, 1), a1 + hstepA, voffA);
            PG8_WAIT_V(8); PG8_WAIT_L(0); PG8_BAR; PG8_MMA(0, 0, At, B0); PG8_MMA(0, 1, At, B1); PG8_BAR; PG8_SCHED;
            PG8_LDA(At, 0, 1); PG8_STAGE(PG8_SB(0, 0), b2, voffB); PG8_STAGE(PG8_SB(0, 1), b2 + hstepB, voffB); PG8_STAGE(PG8_SA(0, 0), a2, voffA);
            PG8_WAIT_V(8); PG8_WAIT_L(0); PG8_BAR; PG8_MMA(1, 0, At, B0); PG8_MMA(1, 1, At, B1); PG8_BAR; PG8_SCHED;
            PG8_LDB(B0, 1, 0); PG8_LDB(B1, 1, 1); PG8_SCHED; PG8_LDA(At, 1, 0); PG8_STAGE(PG8_SA(0, 1), a2 + hstepA, voffA);
            PG8_WAIT_V(8); PG8_WAIT_L(0); PG8_BAR; PG8_MMA(0, 0, At, B0); PG8_MMA(0, 1, At, B1); PG8_BAR; PG8_SCHED;
            PG8_LDA(At, 1, 1); PG8_STAGE(PG8_SB(1, 0), b3, voffB); PG8_STAGE(PG8_SB(1, 1), b3 + hstepB, voffB); PG8_STAGE(PG8_SA(1, 0), a3, voffA);
            PG8_WAIT_V(8); PG8_WAIT_L(0); PG8_BAR; PG8_MMA(1, 0, At, B0); PG8_MMA(1, 1, At, B1); PG8_BAR; PG8_SCHED;
        }
        if (wr == 0) PG8_BAR;
        E(acc, cur, wr, wc, fr, fq);
        if (!has_next) break;
#pragma unroll
        for (int a = 0; a < 2; ++a)
#pragma unroll
            for (int b = 0; b < 2; ++b)
#pragma unroll
                for (int m = 0; m < 4; ++m)
#pragma unroll
                    for (int n = 0; n < 2; ++n) acc[a][b][m][n] = (f32x4){0.f, 0.f, 0.f, 0.f};
        cur = nxt; cA = nA; cB = nB; ++ui;
        if (wr == 1) PG8_BAR;
    }
    PG8_WAIT_V(0);
    PG8_BAR;
#undef PG8_SA
#undef PG8_SB
#undef PG8_STAGE
#undef PG8_LDA
#undef PG8_LDB
#undef PG8_MMA
#undef PG8_WAIT_V
#undef PG8_WAIT_L
#undef PG8_BAR
#undef PG8_SCHED
}
}
using pg8::Unit;

#define EPI_ROWS(...) _Pragma("unroll") for (int ai = 0; ai < 2; ++ai) _Pragma("unroll") for (int m = 0; m < 4; ++m) { const int row = u.pm * 256 + ai * 128 + wr * 64 + m * 16 + fr; __VA_ARGS__ }
#define EPI_COLS(...) _Pragma("unroll") for (int bj = 0; bj < 2; ++bj) { const int col0 = u.pn * 256 + bj * 128 + wc * 32 + 8 * fq; const f32x4 v0 = acc[ai][bj][m][0], v1 = acc[ai][bj][m][1]; __VA_ARGS__ }

struct EpiGemm1 {
    static constexpr bool PERM = true;
    bf16_t* AG; bf16_t* P;
    __device__ __forceinline__ void operator()(const f32x4 (&acc)[2][2][4][2], const Unit& u, int wr, int wc, int fr, int fq) const {
        EPI_ROWS(
            EPI_COLS(
                if (u.pn < 2) {
                    const int g = col0 >> 4, hf = (col0 >> 3) & 1; size_t arow;
                    if (u.z == 0) { const int b = row >> 11, t = row & 2047; arow = (size_t)g * AGR + b * NCL + (t >> 6); }
                    else { const int b = row >> 8, t = row & 255; arow = (size_t)g * AGR + NB * NCL + b * NCC + (t >> 6); }
                    *(u32x4*)(AG + arow * AGK + (row & 63) * GH + hf * 8) = pack8(v0, v1);
                } else {
                    f32x4 a = v0, b = v1;
                    if (u.pn >= 8) {
_Pragma("unroll")
                        for (int e = 0; e < 4; ++e) { a[e] = fsig(a[e]); b[e] = fsig(b[e]); } }
                    *(u32x4*)(P + (size_t)row * PW + (col0 - SW)) = pack8(a, b);
                }
            )
        )
    }
};
struct EpiE {
    static constexpr bool PERM = true;
    float* E;
    __device__ __forceinline__ void operator()(const f32x4 (&acc)[2][2][4][2], const Unit& u, int wr, int wc, int fr, int fq) const {
        EPI_ROWS(
            if (row < AGR) {
                EPI_COLS( float* dst = E + ((size_t)u.z * AGR + row) * 256 + col0; *(f32x4*)dst = v0; *(f32x4*)(dst + 4) = v1; )
            }
        )
    }
};
struct EpiY {
    static constexpr bool PERM = true;
    bf16_t* Z;
    __device__ __forceinline__ void operator()(const f32x4 (&acc)[2][2][4][2], const Unit& u, int wr, int wc, int fr, int fq) const {
        EPI_ROWS(
            const int b = row >> 5; const int c = row & 31;
            EPI_COLS(
                const int i = col0 >> 4, hf = (col0 >> 3) & 1; f32x4 a, bb;
_Pragma("unroll")
                for (int e = 0; e < 4; ++e) { a[e] = fgelu(v0[e]); bb[e] = fgelu(v1[e]); }
                *(u32x4*)(Z + ((size_t)b * SEQ + c * TCH + i) * SW + u.z * GH + hf * 8) = pack8(a, bb);
            )
        )
    }
};
struct EpiGlu {
    static constexpr bool PERM = true;
    const bf16_t* Z; const float* bias; bf16_t* YA;
    __device__ __forceinline__ void operator()(const f32x4 (&acc)[2][2][4][2], const Unit& u, int wr, int wc, int fr, int fq) const {
        f32x4 bv[2][2];
#pragma unroll
        for (int bj = 0; bj < 2; ++bj) { const int col0 = u.pn * 256 + bj * 128 + wc * 32 + 8 * fq; bv[bj][0] = *(const f32x4*)(bias + col0); bv[bj][1] = *(const f32x4*)(bias + col0 + 4); }
        EPI_ROWS(
            EPI_COLS(
                const u32x4 zw = *(const u32x4*)(Z + (size_t)row * SW + col0); f32x4 z0, z1; unpack8(zw, z0, z1); f32x4 a, b;
_Pragma("unroll")
                for (int e = 0; e < 4; ++e) { a[e] = z0[e] * fsig(v0[e] + bv[bj][0][e]); b[e] = z1[e] * fsig(v1[e] + bv[bj][1][e]); }
                *(u32x4*)(YA + (size_t)row * SW + col0) = pack8(a, b);
            )
            if (m & 1) asm volatile("" ::: "memory");
        )
    }
};
template <bool SECOND> struct EpiProj {
    static constexpr bool PERM = true;
    const bf16_t* P; bf16_t* MG;
    __device__ __forceinline__ void operator()(const f32x4 (&acc)[2][2][4][2], const Unit& u, int wr, int wc, int fr, int fq) const {
        EPI_ROWS(
            EPI_COLS(
                const u32x4 gw = *(const u32x4*)(P + (size_t)row * PW + (SECOND ? 2560 : 1536) + col0); f32x4 g0, g1; unpack8(gw, g0, g1);
                f32x4 a = g0 * v0, b = g1 * v1;
                if (SECOND) { const u32x4 ow = *(const u32x4*)(MG + (size_t)row * D + col0); f32x4 o0, o1; unpack8(ow, o0, o1); a += o0; b += o1; }
                *(u32x4*)(MG + (size_t)row * D + col0) = pack8(a, b);
            )
            if (m & 1) asm volatile("" ::: "memory");
        )
    }
};
struct EpiOut {
    static constexpr bool PERM = true;
    const float* x; const float* MOD; const float* n2g; float* X1; bf16_t* X1S; float* SS1;
    __device__ __forceinline__ void operator()(const f32x4 (&acc)[2][2][4][2], const Unit& u, int wr, int wc, int fr, int fq) const {
        const float* md = MOD + (size_t)(u.pm >> 3) * 6 * D;
        f32x4 g1v[2][2], fac[2][2];
#pragma unroll
        for (int bj = 0; bj < 2; ++bj)
#pragma unroll
            for (int n = 0; n < 2; ++n) { const int col = u.pn * 256 + bj * 128 + wc * 32 + 8 * fq + 4 * n;
                g1v[bj][n] = *(const f32x4*)(md + 2 * D + col); fac[bj][n] = *(const f32x4*)(n2g + col) * (*(const f32x4*)(md + 4 * D + col) + 1.f); }
        EPI_ROWS(
            float ss = 0.f;
            EPI_COLS(
                const size_t off = (size_t)row * D + col0;
                const f32x4 a = *(const f32x4*)(x + off) + g1v[bj][0] * v0, b = *(const f32x4*)(x + off + 4) + g1v[bj][1] * v1;
                *(f32x4*)(X1 + off) = a; *(f32x4*)(X1 + off + 4) = b;
                ss += (a[0] * a[0] + a[1] * a[1]) + (a[2] * a[2] + a[3] * a[3]) + (b[0] * b[0] + b[1] * b[1]) + (b[2] * b[2] + b[3] * b[3]);
                *(u32x4*)(X1S + off) = pack8(a * fac[bj][0], b * fac[bj][1]);
            )
            ss += __shfl_xor(ss, 16); ss += __shfl_xor(ss, 32);
            if (fq == 0) unsafeAtomicAdd(SS1 + row, ss);
            if (m & 1) asm volatile("" ::: "memory");
        )
    }
};
struct EpiUp {
    static constexpr bool PERM = true;
    const float* SS1; const float* BIASUP; bf16_t* UP; int row0;
    __device__ __forceinline__ void operator()(const f32x4 (&acc)[2][2][4][2], const Unit& u, int wr, int wc, int fr, int fq) const {
        const float* bu = BIASUP + (size_t)((row0 >> 11) + (u.pm >> 3)) * F2;
        f32x4 bv[2][2];
#pragma unroll
        for (int bj = 0; bj < 2; ++bj) { const int col0 = u.pn * 256 + bj * 128 + wc * 32 + 8 * fq; bv[bj][0] = *(const f32x4*)(bu + col0); bv[bj][1] = *(const f32x4*)(bu + col0 + 4); }
        EPI_ROWS(
            const float rs = rsqrtf(SS1[row0 + row] * (1.f / D) + EPS);
            EPI_COLS( *(u32x4*)(UP + (size_t)row * F2 + col0) = pack8(v0 * rs + bv[bj][0], v1 * rs + bv[bj][1]); )
        )
    }
};
struct EpiDown {
    static constexpr bool PERM = true;
    const float* MOD; float* X; float* SS2; int row0;
    __device__ __forceinline__ void operator()(const f32x4 (&acc)[2][2][4][2], const Unit& u, int wr, int wc, int fr, int fq) const {
        const float* md = MOD + (size_t)((row0 >> 11) + (u.pm >> 3)) * 6 * D + 5 * D;
        f32x4 g2v[2][2];
#pragma unroll
        for (int bj = 0; bj < 2; ++bj) { const int col0 = u.pn * 256 + bj * 128 + wc * 32 + 8 * fq; g2v[bj][0] = *(const f32x4*)(md + col0); g2v[bj][1] = *(const f32x4*)(md + col0 + 4); }
        EPI_ROWS(
            float ss = 0.f;
            EPI_COLS(
                const size_t off = (size_t)(row0 + row) * D + col0;
                const f32x4 a = *(const f32x4*)(X + off) + g2v[bj][0] * v0, b = *(const f32x4*)(X + off + 4) + g2v[bj][1] * v1;
                *(f32x4*)(X + off) = a; *(f32x4*)(X + off + 4) = b;
                ss += (a[0] * a[0] + a[1] * a[1]) + (a[2] * a[2] + a[3] * a[3]) + (b[0] * b[0] + b[1] * b[1]) + (b[2] * b[2] + b[3] * b[3]);
            )
            ss += __shfl_xor(ss, 16); ss += __shfl_xor(ss, 32);
            if (fq == 0) unsafeAtomicAdd(SS2 + row0 + row, ss);
            if (m & 1) asm volatile("" ::: "memory");
        )
    }
};

constexpr int NWAVES = 8, NTHREADS = 512;
constexpr int LDS_BYTES = 147456;
#define LDS_WAIT() asm volatile("s_waitcnt lgkmcnt(0)" ::: "memory")

enum Phase { PH_PRO = 0, PH_NORM1, PH_GEMM1, PH_SSME, PH_SCAN, PH_SSMY, PH_GLU, PH_PROJ, PH_OUT, PH_UP0, PH_CONV0, PH_DOWN0UP1, PH_CONV1, PH_DOWN1, PH_FINAL, PH_COUNT };

struct Args { const float* in[27]; float* out; unsigned char* ws; int ph_lo, ph_hi; };

__device__ __forceinline__ void transpose_item(const float* W, int K, int N, bf16_t* WT, LAS float* scr, int item, int lane) {
    const int nblk = N / 32, kb = item / nblk, nb = item % nblk, k0 = 64 * kb, n0 = 32 * nb;
#pragma unroll
    for (int i = 0; i < 32; ++i) { const int kk = 2 * i + (lane >> 5); scr[kk * 33 + (lane & 31)] = W[(size_t)(k0 + kk) * N + n0 + (lane & 31)]; }
    LDS_WAIT(); asm volatile("" ::: "memory");
    const int c = lane & 7;
#pragma unroll
    for (int j = 0; j < 4; ++j) { const int n = (lane >> 3) + 8 * j; const LAS float* s = scr + (8 * c) * 33 + n;
        u32x4 o; o.x = cvt_pk_bf16(s[0 * 33], s[1 * 33]); o.y = cvt_pk_bf16(s[2 * 33], s[3 * 33]); o.z = cvt_pk_bf16(s[4 * 33], s[5 * 33]); o.w = cvt_pk_bf16(s[6 * 33], s[7 * 33]);
        *(u32x4*)(WT + (size_t)(n0 + n) * K + k0 + 8 * c) = o; }
    LDS_WAIT(); asm volatile("" ::: "memory");
}
template <int R, bool SILU, class RowPtr>
__device__ __forceinline__ void gemv_task(LAS float* scr, const RowPtr& rp, const float* W, int ldw, int n0, int k0, int nk, float* OUT, int ldo, const float* bias, int lane) {
    float acc[R];
#pragma unroll
    for (int r = 0; r < R; ++r) acc[r] = 0.f;
    const int n = n0 + lane;
    for (int ks = 0; ks < nk; ks += 64) {
#pragma unroll
        for (int r = 0; r < R; ++r) { float v = rp(r)[k0 + ks + lane]; if (SILU) v = v * fsig(v); scr[lane * 36 + r] = v; }
        LDS_WAIT(); asm volatile("" ::: "memory");
#pragma unroll 1
        for (int kh = 0; kh < 64; kh += 32) { float w[32];
#pragma unroll
            for (int kk = 0; kk < 32; ++kk) w[kk] = W[(size_t)(k0 + ks + kh + kk) * ldw + n];
#pragma unroll
            for (int kk = 0; kk < 32; ++kk) {
#pragma unroll
                for (int r = 0; r < R; ++r) acc[r] += scr[(kh + kk) * 36 + r] * w[kk]; } }
        LDS_WAIT(); asm volatile("" ::: "memory");
    }
    const float bz = (bias && k0 == 0) ? bias[n] : 0.f;
#pragma unroll
    for (int r = 0; r < R; ++r) unsafeAtomicAdd(OUT + (size_t)r * ldo + n, acc[r] + bz);
}
struct ModRows { const float* c; const float* c_ctx; __device__ __forceinline__ const float* operator()(int r) const { return r < NB ? c + (size_t)r * D : c_ctx; } };
struct Sh2Rows { const float* MOD; __device__ __forceinline__ const float* operator()(int r) const { return MOD + (size_t)r * 6 * D + 3 * D; } };


__device__ __forceinline__ void conv_phase(LAS unsigned char* wl, const bf16_t* UP, const float* conv_w, bf16_t* ACT, const unsigned char* zeros, int gw, int NGW, int lane) {
    constexpr int SLOT = 3072, NSLOT = 5, NTASK = (HALF_ROWS / SEQ) * 88 * 4;
    const int q = lane & 7, t0 = lane >> 3;
    const unsigned char* upb = (const unsigned char*)UP;
    for (int task = gw; task < NTASK; task += NGW) {
        const int strip = task & 3, slab = (task >> 2) % 88, b = task / 352, c0 = strip * 16, ch0 = slab * 32;
        f32x4 wa[9], wv[9];
#pragma unroll
        for (int k = 0; k < 9; ++k) { wa[k] = *(const f32x4*)(conv_w + k * F2 + ch0 + q * 4); wv[k] = *(const f32x4*)(conv_w + k * F2 + FH + ch0 + q * 4); }
        unsigned off[3]; bool ok[3]; unsigned zoff[3];
#pragma unroll
        for (int i = 0; i < 3; ++i) { const int e = i * 64 + lane, part = e / 72, tk = (e % 72) >> 2, pc = e & 3, col = c0 - 1 + tk;
            ok[i] = (e < 144) && col >= 0 && col < 64; zoff[i] = (unsigned)pc * 16u;
            off[i] = (unsigned)((((size_t)b * SEQ + col) * F2 + (size_t)part * FH + ch0) * 2 + pc * 16); }
#define CONV_ISSUE(s_) do { const int s__ = (s_); const int r__ = s__ - 1; const bool rok = (r__ >= 0) && (r__ < 32); const int sl__ = s__ % NSLOT; \
        _Pragma("unroll") for (int i = 0; i < 3; ++i) { const unsigned char* src = (rok && ok[i]) ? upb + off[i] + (size_t)r__ * (64 * F2 * 2) : zeros + zoff[i]; \
            __builtin_amdgcn_global_load_lds((const unsigned*)src, (LAS unsigned*)(wl + sl__ * SLOT + i * 1024), 16, 0, 0); } } while (0)
        asm volatile("s_waitcnt lgkmcnt(0)" ::: "memory");
#pragma unroll 1
        for (int s0 = 0; s0 < 5; ++s0) CONV_ISSUE(s0);
#pragma unroll 1
        for (int r = 0; r < 32; ++r) {
            if (r < 30) asm volatile("s_waitcnt vmcnt(6)" ::: "memory"); else if (r == 30) asm volatile("s_waitcnt vmcnt(3)" ::: "memory"); else asm volatile("s_waitcnt vmcnt(0)" ::: "memory");
            const int sb0 = (r % NSLOT) * SLOT, sb1 = ((r + 1) % NSLOT) * SLOT, sb2 = ((r + 2) % NSLOT) * SLOT;
#pragma unroll
            for (int tt = 0; tt < 2; ++tt) { const int tk = t0 + 8 * tt;
                f32x4 sa = {0.f, 0.f, 0.f, 0.f}, sv = {0.f, 0.f, 0.f, 0.f};
#pragma unroll
                for (int ky = 0; ky < 3; ++ky) { const int sb = ky == 0 ? sb0 : (ky == 1 ? sb1 : sb2);
#pragma unroll
                    for (int kx = 0; kx < 3; ++kx) { const LAS unsigned char* p = wl + sb + (tk + kx) * 64 + q * 8;
                        const u32x2 ua = *(const LAS u32x2*)p, uv = *(const LAS u32x2*)(p + 1152);
                        const f32x4 fa = {__uint_as_float(ua.x << 16), __uint_as_float(ua.x & 0xffff0000u), __uint_as_float(ua.y << 16), __uint_as_float(ua.y & 0xffff0000u)};
                        const f32x4 fv = {__uint_as_float(uv.x << 16), __uint_as_float(uv.x & 0xffff0000u), __uint_as_float(uv.y << 16), __uint_as_float(uv.y & 0xffff0000u)};
                        sa += wa[ky * 3 + kx] * fa; sv += wv[ky * 3 + kx] * fv; } }
                f32x4 o;
#pragma unroll
                for (int e = 0; e < 4; ++e) o[e] = sa[e] * fsig(sa[e]) * sv[e];
                u32x2 w; w.x = cvt_pk_bf16(o[0], o[1]); w.y = cvt_pk_bf16(o[2], o[3]);
                *(u32x2*)(ACT + ((size_t)b * SEQ + r * 64 + c0 + tk) * FH + ch0 + q * 4) = w; }
            asm volatile("s_waitcnt lgkmcnt(0)" ::: "memory");
            if (r + 5 < 34) CONV_ISSUE(r + 5);
        }
#undef CONV_ISSUE
    }
}

__global__ void __launch_bounds__(NTHREADS, 2) mega(Args a) {
    extern __shared__ __attribute__((aligned(16))) unsigned char lds_raw[];
    LAS unsigned char* lds = (LAS unsigned char*)lds_raw;
    cg::grid_group grid = cg::this_grid();
    const int tid = threadIdx.x, lane = tid & 63, wave = __builtin_amdgcn_readfirstlane(tid >> 6);
    const int G = gridDim.x, bx = blockIdx.x;
    const int gw = bx * NWAVES + wave, NGW = G * NWAVES;
    const int gt = bx * NTHREADS + tid, NGT = G * NTHREADS;
    unsigned char* ws = a.ws;
    const float* x = a.in[0]; const float* cvec = a.in[1]; const float* ctx = a.in[2]; const float* c_ctx = a.in[3];
    const float* mod_w = a.in[4]; const float* mod_b = a.in[5]; const float* n1g = a.in[6]; const float* n2g = a.in[7];
    const float* w_in = a.in[8]; const float* lam_re = a.in[9]; const float* lam_im = a.in[10]; const float* log_dt = a.in[11];
    const float* b_re = a.in[12]; const float* b_im = a.in[13]; const float* c_re = a.in[14]; const float* c_im = a.in[15];
    const float* ssm_d = a.in[16]; const float* glu_w = a.in[17]; const float* glu_b = a.in[18]; const float* sconv_w = a.in[19];
    const float* proj_a = a.in[20]; const float* proj_b = a.in[21]; const float* w_out = a.in[22]; const float* w_up = a.in[23];
    const float* conv_w = a.in[24]; const float* w_down = a.in[25]; const float* final_g = a.in[26];
    float* out = a.out;
    float* MOD = (float*)(ws + WS_MOD); float* BIASUP = (float*)(ws + WS_BIASUP); float* SS1 = (float*)(ws + WS_SS1); float* SS2 = (float*)(ws + WS_SS2);
    bf16_t* WIN = (bf16_t*)(ws + WS_WIN); bf16_t* WGLU = (bf16_t*)(ws + WS_WGLU); bf16_t* WPA = (bf16_t*)(ws + WS_WPA); bf16_t* WPB = (bf16_t*)(ws + WS_WPB);
    bf16_t* WOUT = (bf16_t*)(ws + WS_WOUT); bf16_t* WUP = (bf16_t*)(ws + WS_WUP); bf16_t* WDOWN = (bf16_t*)(ws + WS_WDOWN);
    bf16_t* OP = (bf16_t*)(ws + WS_OP); bf16_t* WE = (bf16_t*)(ws + WS_WE);
    bf16_t* P = (bf16_t*)(ws + WS_P); bf16_t* H = (bf16_t*)(ws + WS_H); bf16_t* AG = (bf16_t*)(ws + WS_AG); float* E = (float*)(ws + WS_E);
    bf16_t* YBR = (bf16_t*)(ws + WS_YBR); bf16_t* Z = (bf16_t*)(ws + WS_Z); bf16_t* YA = (bf16_t*)(ws + WS_YA); bf16_t* MG = (bf16_t*)(ws + WS_MERGED);
    bf16_t* X1S = (bf16_t*)(ws + WS_X1S); bf16_t* UP = (bf16_t*)(ws + WS_UP); bf16_t* ACT = (bf16_t*)(ws + WS_ACT);
    float* KT = (float*)(ws + WS_KT); f32x2* APW = (f32x2*)(ws + WS_APW);
    LAS float* wscr = (LAS float*)(lds + wave * 16384);

    const int lo = a.ph_lo, hi = a.ph_hi;
#define IN(k) (lo <= (k) && (k) < hi)
#define REPS(k) (((PROBE_DUP >> (k)) & 1) ? 2 : 1)
#define SEAM(k) do { if (IN(k) && IN((k) + 1)) grid.sync(); } while (0)

    if (IN(PH_PRO)) for (int rep = 0; rep < REPS(PH_PRO); ++rep) {
        if (rep) __syncthreads();
        for (int i = gt; i < NG * 2 * 65 * PS; i += NGT) {
            const int p = i & 63, e = (i >> 6) % 65, gd = i / (65 * 64), dir = gd & 1, g = gd >> 1;
            const float dt = expf(log_dt[dir * NG + g]); float pr, pi;
            ssm_apow(lam_re[(dir * NG + g) * PS + p], lam_im[(dir * NG + g) * PS + p], dt, (float)e, pr, pi);
            APW[i] = (f32x2){pr, pi};
        }
        for (int task = bx; task < NG * 8; task += G) {
            const int g = task >> 3, ts = task & 7;
            LAS f32x2* s_apw = (LAS f32x2*)lds;
            LAS f32x2* s_bb = (LAS f32x2*)(lds + 8192);
            LAS f32x2* s_cc = (LAS f32x2*)(lds + 8192 + 16384);
            for (int i = tid; i < 1024; i += NTHREADS) { const int dir = i >> 9, tt = (i >> 6) & 7, p = i & 63; const float dt = expf(log_dt[dir * NG + g]); float pr, pi;
                ssm_apow(lam_re[(dir * NG + g) * PS + p], lam_im[(dir * NG + g) * PS + p], dt, (float)(ts * 8 + tt), pr, pi); s_apw[i] = (f32x2){pr, pi}; }
            for (int i = tid; i < 2048; i += NTHREADS) { const int dir = i >> 10, p = (i >> 4) & 63, hp = i & 15; const float dt = expf(log_dt[dir * NG + g]); float ar, ai, qr, qi;
                ssm_disc(lam_re[(dir * NG + g) * PS + p], lam_im[(dir * NG + g) * PS + p], dt, ar, ai, qr, qi);
                const size_t bi = (((size_t)dir * NG + g) * PS + p) * GH + hp; const float tr = b_re[bi], ti = b_im[bi];
                s_bb[i] = (f32x2){qr * tr - qi * ti, qr * ti + qi * tr}; }
            for (int i = tid; i < 2048; i += NTHREADS) { const int dir = i >> 10, h = (i >> 6) & 15, p = i & 63; const size_t ci = (((size_t)dir * NG + g) * GH + h) * PS + p;
                s_cc[i] = (f32x2){c_re[ci], c_im[ci]}; }
            __syncthreads();
#pragma unroll 1
            for (int e = 0; e < 8; ++e) { const int o = tid + NTHREADS * e; const int dir = o >> 11, tt = (o >> 8) & 7, h = (o >> 4) & 15, hp = o & 15;
                float s = 0.f;
                for (int p = 0; p < PS; ++p) { const f32x2 cc = s_cc[(dir * 16 + h) * 64 + p], aw = s_apw[(dir * 8 + tt) * 64 + p], bb = s_bb[(dir * 64 + p) * 16 + hp];
                    const float car = cc.x * aw.x - cc.y * aw.y, cai = cc.x * aw.y + cc.y * aw.x; s += car * bb.x - cai * bb.y; }
                KT[((((size_t)g * 2 + dir) * 64 + ts * 8 + tt) * 16 + h) * 16 + hp] = s; }
            __syncthreads();
        }
        {
            constexpr int I_IN = (D / 64) * (PCOLS / 32), I_GLU = (SW / 64) * (SW / 32), I_PA = (SW / 64) * (D / 32), I_OUT = (D / 64) * (D / 32), I_UP = (D / 64) * (F2 / 32), I_DN = (FH / 64) * (D / 32);
            constexpr int NITEMS = I_IN + I_GLU + 2 * I_PA + I_OUT + I_UP + I_DN;
            for (int it = gw; it < NITEMS; it += NGW) {
                int r = it;
                if (r < I_IN) { transpose_item(w_in, D, PCOLS, WIN, wscr, r, lane); continue; } r -= I_IN;
                if (r < I_GLU) { transpose_item(glu_w, SW, SW, WGLU, wscr, r, lane); continue; } r -= I_GLU;
                if (r < I_PA) { transpose_item(proj_a, SW, D, WPA, wscr, r, lane); continue; } r -= I_PA;
                if (r < I_PA) { transpose_item(proj_b, SW, D, WPB, wscr, r, lane); continue; } r -= I_PA;
                if (r < I_OUT) { transpose_item(w_out, D, D, WOUT, wscr, r, lane); continue; } r -= I_OUT;
                if (r < I_UP) { transpose_item(w_up, D, F2, WUP, wscr, r, lane); continue; } r -= I_UP;
                transpose_item(w_down, FH, D, WDOWN, wscr, r, lane);
            }
        }
        if (rep == 0) {
            const ModRows rp{cvec, c_ctx};
            for (int task = NGW - 1 - gw; task < (6 * D / 64) * 16; task += NGW) { const int cb = task >> 4, ks = task & 15;
                gemv_task<NB + 1, true>(wscr, rp, mod_w, 6 * D, cb * 64, ks * 64, 64, MOD, 6 * D, mod_b, lane); }
        }
    }
    SEAM(PH_PRO);

    if (IN(PH_NORM1)) for (int rep = 0; rep < REPS(PH_NORM1); ++rep) {
        for (int task = gw; task < NG * 256; task += NGW) {
            const int g = task >> 8, n = task & 255, dir = n >> 7, ri = (n >> 6) & 1, p = n & 63;
            const int j = lane, e = dir ? j : 63 - j;
            const f32x2 pw = APW[(((size_t)g * 2 + dir) * 65 + e) * 64 + p];
            const float dt = expf(log_dt[dir * NG + g]); float ar, ai, qr, qi;
            ssm_disc(lam_re[(dir * NG + g) * PS + p], lam_im[(dir * NG + g) * PS + p], dt, ar, ai, qr, qi);
            const float wr_ = pw.x * qr - pw.y * qi, wi_ = pw.x * qi + pw.y * qr;
            const float* br = b_re + (((size_t)dir * NG + g) * PS + p) * GH; const float* bi = b_im + (((size_t)dir * NG + g) * PS + p) * GH;
            float v[16];
#pragma unroll
            for (int hp = 0; hp < 16; ++hp) v[hp] = ri ? (wr_ * bi[hp] + wi_ * br[hp]) : (wr_ * br[hp] - wi_ * bi[hp]);
            bf16_t* dst = WE + ((size_t)g * 256 + n) * 1024 + j * 16;
            u32x4 w0, w1; w0.x = cvt_pk_bf16(v[0], v[1]); w0.y = cvt_pk_bf16(v[2], v[3]); w0.z = cvt_pk_bf16(v[4], v[5]); w0.w = cvt_pk_bf16(v[6], v[7]);
            w1.x = cvt_pk_bf16(v[8], v[9]); w1.y = cvt_pk_bf16(v[10], v[11]); w1.z = cvt_pk_bf16(v[12], v[13]); w1.w = cvt_pk_bf16(v[14], v[15]);
            *(u32x4*)dst = w0; *(u32x4*)(dst + 8) = w1;
        }
        for (int task = gw; task < NG * 1024; task += NGW) {
            const int g = task >> 10, n = task & 1023, i = n >> 4, h = n & 15;
            bf16_t* dst = OP + ((size_t)g * 1024 + n) * AGK;
            const float* kt0 = KT + (((size_t)g * 2 + 0) * 64) * 256 + h * 16; const float* kt1 = KT + (((size_t)g * 2 + 1) * 64) * 256 + h * 16;
#pragma unroll
            for (int pass = 0; pass < 2; ++pass) { const int ch = lane + 64 * pass, j = ch >> 1, hh = (ch & 1) * 8;
                f32x4 a, b;
                if (j < i) { const float* s = kt0 + (size_t)(i - j) * 256 + hh; a = *(const f32x4*)s; b = *(const f32x4*)(s + 4); }
                else if (j > i) { const float* s = kt1 + (size_t)(j - i) * 256 + hh; a = *(const f32x4*)s; b = *(const f32x4*)(s + 4); }
                else { const float* s0 = kt0 + hh; const float* s1 = kt1 + hh; a = *(const f32x4*)s0 + *(const f32x4*)s1; b = *(const f32x4*)(s0 + 4) + *(const f32x4*)(s1 + 4);
                    const float dd = ssm_d[g * GH + h];
#pragma unroll
                    for (int e = 0; e < 4; ++e) { if (hh + e == h) a[e] += dd; if (hh + 4 + e == h) b[e] += dd; } }
                *(u32x4*)(dst + ch * 8) = pack8(a, b); }
            if (lane < 32) { const int kk0 = lane * 8, dir = kk0 >> 7, ri = (kk0 >> 6) & 1, p0 = kk0 & 63; const int e = dir ? 64 - i : i + 1;
                const f32x2* pw = APW + (((size_t)g * 2 + dir) * 65 + e) * 64 + p0; const size_t ci = (((size_t)dir * NG + g) * GH + h) * PS + p0;
                float v[8];
#pragma unroll
                for (int q = 0; q < 8; ++q) { const f32x2 w = pw[q]; const float cr = c_re[ci + q], cim = c_im[ci + q]; v[q] = ri ? -(cr * w.y + cim * w.x) : (cr * w.x - cim * w.y); }
                u32x4 o; o.x = cvt_pk_bf16(v[0], v[1]); o.y = cvt_pk_bf16(v[2], v[3]); o.z = cvt_pk_bf16(v[4], v[5]); o.w = cvt_pk_bf16(v[6], v[7]);
                *(u32x4*)(dst + 1024 + kk0) = o; }
        }
        if (rep == 0) {
            const Sh2Rows rp{MOD};
            for (int task = NGW - 1 - gw; task < (F2 / 64) * 16; task += NGW) { const int cb = task >> 4, ks = task & 15;
                gemv_task<NB, false>(wscr, rp, w_up, F2, cb * 64, ks * 64, 64, BIASUP, F2, nullptr, lane); }
        }
        for (int row0 = gw; row0 < M + MC; row0 += 4 * NGW) {
            f32x4 v[4][4]; float ss[4];
#pragma unroll
            for (int u = 0; u < 4; ++u) { const int row = row0 + u * NGW; ss[u] = 0.f;
                if (row < M + MC) { const float* xr = row < M ? x + (size_t)row * D : ctx + (size_t)(row - M) * D;
#pragma unroll
                    for (int jq = 0; jq < 4; ++jq) v[u][jq] = *(const f32x4*)(xr + 4 * lane + 256 * jq); } }
#pragma unroll
            for (int u = 0; u < 4; ++u) { const int row = row0 + u * NGW;
                if (row < M + MC) {
#pragma unroll
                    for (int jq = 0; jq < 4; ++jq) ss[u] += (v[u][jq][0] * v[u][jq][0] + v[u][jq][1] * v[u][jq][1]) + (v[u][jq][2] * v[u][jq][2] + v[u][jq][3] * v[u][jq][3]); } }
#pragma unroll
            for (int o = 1; o < 64; o <<= 1) {
#pragma unroll
                for (int u = 0; u < 4; ++u) ss[u] += __shfl_xor(ss[u], o); }
#pragma unroll
            for (int u = 0; u < 4; ++u) { const int row = row0 + u * NGW;
                if (row < M + MC) { const int mr = row < M ? (row >> 11) : NB; const float* sh = MOD + (size_t)mr * 6 * D; const float* sc = sh + D;
                    const float r = rsqrtf(ss[u] * (1.f / D) + EPS);
#pragma unroll
                    for (int jq = 0; jq < 4; ++jq) { const int col = 4 * lane + 256 * jq;
                        const f32x4 o = v[u][jq] * r * *(const f32x4*)(n1g + col) * (*(const f32x4*)(sc + col) + 1.f) + *(const f32x4*)(sh + col);
                        u32x2 w; w.x = cvt_pk_bf16(o[0], o[1]); w.y = cvt_pk_bf16(o[2], o[3]); *(u32x2*)(H + (size_t)row * D + col) = w; } } }
        }
    }
    SEAM(PH_NORM1);

    if (IN(PH_GEMM1)) {
        const EpiGemm1 Ep{AG, P};
        { pg8::PlainSched S; S.init(H, D, WIN, D, M, PCOLS, G, bx, 0); S.reps = REPS(PH_GEMM1); pg8::gemm_phase(lds, D, D, D, S, Ep); }
        { pg8::PlainSched S; S.init(H + (size_t)M * D, D, WIN, D, MC, SW, G, bx, 1); pg8::gemm_phase(lds, D, D, D, S, Ep); }
    }
    SEAM(PH_GEMM1);

    if (IN(PH_SSME)) {
        { pg8::BatchSched S; S.init(AG, AGK, (size_t)AGR * AGK * 2, WE, 1024, (size_t)256 * 1024 * 2, 5, 1, NG, G, bx); pg8::gemm_phase(lds, 1024, AGK, 1024, S, EpiE{E}); }
        {
            const int q = tid & 63, rl = tid >> 6; f32x4 w[3][2];
#pragma unroll
            for (int k = 0; k < 3; ++k) { w[k][0] = *(const f32x4*)(sconv_w + k * SW + q * 8); w[k][1] = *(const f32x4*)(sconv_w + k * SW + q * 8 + 4); }
            volatile LAS int* s_chunk = (volatile LAS int*)(lds + 131072 + 64);
            unsigned* cnt = (unsigned*)(ws + WS_YBRCNT);
            for (;;) {
                __syncthreads();
                if (tid == 0) *s_chunk = (int)__hip_atomic_fetch_add(cnt, 1u, __ATOMIC_RELAXED, __HIP_MEMORY_SCOPE_AGENT);
                __syncthreads();
                const int chunk = *s_chunk; if (chunk >= M / 128) break;
#pragma unroll 1
                for (int it = 0; it < 16; it += 2) {
                    u32x4 cw[2][3], xw[2][3], gwd[2];
#pragma unroll
                    for (int u = 0; u < 2; ++u) { const int m = chunk * 128 + (it + u) * 8 + rl, t = m & 2047;
#pragma unroll
                        for (int k = 0; k < 3; ++k) { const int tt = t + k - 1; const bool okk = tt >= 0 && tt < SEQ; const bf16_t* pr = P + (size_t)(okk ? m + k - 1 : m) * PW + q * 8;
                            cw[u][k] = *(const u32x4*)(pr + 512); xw[u][k] = *(const u32x4*)(pr + 1024); if (!okk) { cw[u][k] = (u32x4){0u, 0u, 0u, 0u}; xw[u][k] = (u32x4){0u, 0u, 0u, 0u}; } }
                        gwd[u] = *(const u32x4*)(P + (size_t)m * PW + q * 8); }
#pragma unroll
                    for (int u = 0; u < 2; ++u) { const int m = chunk * 128 + (it + u) * 8 + rl; f32x4 s0 = {0.f, 0.f, 0.f, 0.f}, s1 = {0.f, 0.f, 0.f, 0.f};
#pragma unroll
                        for (int k = 0; k < 3; ++k) { f32x4 c0, c1, x0, x1; unpack8(cw[u][k], c0, c1); unpack8(xw[u][k], x0, x1); s0 += w[k][0] * (c0 * x0); s1 += w[k][1] * (c1 * x1); }
                        f32x4 g0, g1; unpack8(gwd[u], g0, g1);
                        *(u32x4*)(YBR + (size_t)m * SW + q * 8) = pack8(g0 * s0, g1 * s1); }
                }
            }
        }
    }
    SEAM(PH_SSME);

    if (IN(PH_SCAN)) for (int rep = 0; rep < REPS(PH_SCAN); ++rep) {
        for (int idx = gt; idx < NB * NG * 2 * PS; idx += NGT) {
            const int p = idx & 63, dir = (idx >> 6) & 1, g = (idx >> 7) & 31, b = idx >> 12;
            const f32x2 aT = APW[(((size_t)g * 2 + dir) * 65 + 64) * 64 + p];
            const float* Eg = E + (size_t)g * AGR * 256 + dir * 128 + p;
            bf16_t* Sg = AG + (size_t)g * AGR * AGK + 1024 + dir * 128 + p;
            float er[NCC + NCL], ei[NCC + NCL];
#pragma unroll
            for (int cc = 0; cc < NCC; ++cc) { const int c = dir ? NCC - 1 - cc : cc; const int row = NB * NCL + b * NCC + c; er[cc] = Eg[(size_t)row * 256]; ei[cc] = Eg[(size_t)row * 256 + 64]; }
#pragma unroll
            for (int cc = 0; cc < NCL; ++cc) { const int c = dir ? NCL - 1 - cc : cc; const int row = b * NCL + c; er[NCC + cc] = Eg[(size_t)row * 256]; ei[NCC + cc] = Eg[(size_t)row * 256 + 64]; }
            float sr = 0.f, si = 0.f;
#pragma unroll
            for (int cc = 0; cc < NCC; ++cc) { const float nr = aT.x * sr - aT.y * si + er[cc], ni = aT.x * si + aT.y * sr + ei[cc]; sr = nr; si = ni; }
#pragma unroll
            for (int cc = 0; cc < NCL; ++cc) { const int c = dir ? NCL - 1 - cc : cc; const int row = b * NCL + c;
                Sg[(size_t)row * AGK] = f2bf(sr); Sg[(size_t)row * AGK + 64] = f2bf(si);
                const float nr = aT.x * sr - aT.y * si + er[NCC + cc], ni = aT.x * si + aT.y * sr + ei[NCC + cc]; sr = nr; si = ni; }
        }
    }
    SEAM(PH_SCAN);

    if (IN(PH_SSMY)) {
        pg8::BatchSched S; S.init(AG, AGK, (size_t)AGR * AGK * 2, OP, AGK, (size_t)1024 * AGK * 2, 4, 4, NG, G, bx); pg8::gemm_phase(lds, AGK, AGK, AGK, S, EpiY{Z});
    }
    SEAM(PH_SSMY);

    if (IN(PH_GLU)) { pg8::PlainSched S; S.init(Z, SW, WGLU, SW, M, SW, G, bx, 0); pg8::gemm_phase(lds, SW, SW, SW, S, EpiGlu{Z, glu_b, YA}); }
    SEAM(PH_GLU);

    if (IN(PH_PROJ)) {
        { pg8::PlainSched S; S.init(YA, SW, WPA, SW, M, D, G, bx, 0); pg8::gemm_phase(lds, SW, SW, SW, S, EpiProj<false>{P, MG}); }
        { pg8::PlainSched S; S.init(YBR, SW, WPB, SW, M, D, G, bx, 0); pg8::gemm_phase(lds, SW, SW, SW, S, EpiProj<true>{P, MG}); }
    }
    SEAM(PH_PROJ);

    if (IN(PH_OUT)) { pg8::PlainSched S; S.init(MG, D, WOUT, D, M, D, G, bx, 0); pg8::gemm_phase(lds, D, D, D, S, EpiOut{x, MOD, n2g, out, X1S, SS1}); }
    SEAM(PH_OUT);

    if (IN(PH_UP0)) { pg8::PlainSched S; S.init(X1S, D, WUP, D, HALF_ROWS, F2, G, bx, 0); S.reps = REPS(PH_UP0); pg8::gemm_phase(lds, D, D, D, S, EpiUp{SS1, BIASUP, UP, 0}); }
    SEAM(PH_UP0);
    if (IN(PH_CONV0)) for (int rep = 0; rep < REPS(PH_CONV0); ++rep) conv_phase(lds + wave * 16384, UP, conv_w, ACT, ws + WS_ZEROS, gw, NGW, lane);
    SEAM(PH_CONV0);
    if (IN(PH_DOWN0UP1)) {
        { pg8::PlainSched S; S.init(ACT, FH, WDOWN, FH, HALF_ROWS, D, G, bx, 0); pg8::gemm_phase(lds, FH, FH, FH, S, EpiDown{MOD, out, SS2, 0}); }
        { pg8::PlainSched S; S.init(X1S + (size_t)HALF_ROWS * D, D, WUP, D, HALF_ROWS, F2, G, bx, 0); pg8::gemm_phase(lds, D, D, D, S, EpiUp{SS1, BIASUP, UP, HALF_ROWS}); }
    }
    SEAM(PH_DOWN0UP1);
    if (IN(PH_CONV1)) for (int rep = 0; rep < REPS(PH_CONV1); ++rep) conv_phase(lds + wave * 16384, UP, conv_w, ACT, ws + WS_ZEROS, gw, NGW, lane);
    SEAM(PH_CONV1);
    if (IN(PH_DOWN1)) { pg8::PlainSched S; S.init(ACT, FH, WDOWN, FH, HALF_ROWS, D, G, bx, 0); pg8::gemm_phase(lds, FH, FH, FH, S, EpiDown{MOD, out, SS2, HALF_ROWS}); }
    SEAM(PH_DOWN1);

    if (IN(PH_FINAL)) {
        const int cq = gt & 255; const f32x4 fg = *(const f32x4*)(final_g + cq * 4); const int rstride = NGT >> 8;
        for (int row = gt >> 8; row < M; row += 8 * rstride) {
            f32x4 v[8]; float rs[8];
#pragma unroll
            for (int u = 0; u < 8; ++u) { const int rr = row + u * rstride; if (rr < M) { v[u] = *(const f32x4*)(out + (size_t)rr * D + cq * 4); rs[u] = SS2[rr]; } }
#pragma unroll
            for (int u = 0; u < 8; ++u) { const int rr = row + u * rstride; if (rr < M) *(f32x4*)(out + (size_t)rr * D + cq * 4) = v[u] * rsqrtf(rs[u] * (1.f / D) + EPS) * fg; }
        }
    }
}

extern "C" void kernel_launch(void* const* d_in, const int* in_sizes, int n_in, void* d_out, int out_size, void* d_ws, size_t ws_size, hipStream_t stream) {
    static int grid = 0;
    if (grid == 0) {
        if (n_in != 27 || ws_size < WS_NEED || out_size != M * D) { fprintf(stderr, "kernel_launch: bad args n_in=%d ws=%zu out=%d\n", n_in, ws_size, out_size); grid = -1; return; }
        int dev = 0, cus = 0, per_cu = 0;
        if (hipGetDevice(&dev) != hipSuccess || hipDeviceGetAttribute(&cus, hipDeviceAttributeMultiprocessorCount, dev) != hipSuccess) { grid = -1; return; }
        if (hipFuncSetAttribute((const void*)mega, hipFuncAttributeMaxDynamicSharedMemorySize, LDS_BYTES) != hipSuccess) { fprintf(stderr, "kernel_launch: hipFuncSetAttribute failed\n"); grid = -1; return; }
        if (hipOccupancyMaxActiveBlocksPerMultiprocessor(&per_cu, (const void*)mega, NTHREADS, LDS_BYTES) != hipSuccess || per_cu < 1) { fprintf(stderr, "kernel_launch: occupancy query says %d\n", per_cu); (void)hipGetLastError(); grid = -1; return; }
        grid = cus;
        if (grid % 8 != 0) { fprintf(stderr, "kernel_launch: CU count %d not a multiple of 8\n", grid); grid = -1; return; }
    }
    if (grid < 0) return;
    const float* x = (const float*)d_in[0]; const float* c = (const float*)d_in[1]; const float* ctx = (const float*)d_in[2]; const float* c_ctx = (const float*)d_in[3];
    const float* mod_w = (const float*)d_in[4]; const float* mod_b = (const float*)d_in[5]; const float* n1g = (const float*)d_in[6]; const float* n2g = (const float*)d_in[7];
    const float* w_in = (const float*)d_in[8]; const float* lam_re = (const float*)d_in[9]; const float* lam_im = (const float*)d_in[10]; const float* log_dt = (const float*)d_in[11];
    const float* b_re = (const float*)d_in[12]; const float* b_im = (const float*)d_in[13]; const float* c_re = (const float*)d_in[14]; const float* c_im = (const float*)d_in[15];
    const float* ssm_d = (const float*)d_in[16]; const float* glu_w = (const float*)d_in[17]; const float* glu_b = (const float*)d_in[18]; const float* sconv_w = (const float*)d_in[19];
    const float* proj_a = (const float*)d_in[20]; const float* proj_b = (const float*)d_in[21]; const float* w_out = (const float*)d_in[22]; const float* w_up = (const float*)d_in[23];
    const float* conv_w = (const float*)d_in[24]; const float* w_down = (const float*)d_in[25]; const float* final_g = (const float*)d_in[26];
    unsigned char* ws = (unsigned char*)d_ws; float* out = (float*)d_out;
    float* MOD = (float*)(ws + WS_MOD); float* BIASUP = (float*)(ws + WS_BIASUP); float* SS1 = (float*)(ws + WS_SS1); float* SS2 = (float*)(ws + WS_SS2);
    bf16_t* P = (bf16_t*)(ws + WS_P); bf16_t* H = (bf16_t*)(ws + WS_H); bf16_t* AG = (bf16_t*)(ws + WS_AG);
    bf16_t* YBR = (bf16_t*)(ws + WS_YBR); bf16_t* Z = (bf16_t*)(ws + WS_Z); bf16_t* YA = (bf16_t*)(ws + WS_YA); bf16_t* MG = (bf16_t*)(ws + WS_MERGED);
    bf16_t* X1S = (bf16_t*)(ws + WS_X1S); bf16_t* UP = (bf16_t*)(ws + WS_UP); bf16_t* ACT = (bf16_t*)(ws + WS_ACT);
    float* YF = (float*)(ws + WS_H);

    (void)hipMemsetAsync(ws + WS_CTL, 0, CTL_ZERO_BYTES, stream);
    Args a{};
    for (int i = 0; i < 27; ++i) a.in[i] = (const float*)d_in[i];
    a.out = out; a.ws = ws;
#define RUN(lo_, hi_) do { a.ph_lo = (lo_); a.ph_hi = (hi_); hipLaunchKernelGGL(mega, dim3(grid), dim3(NTHREADS), LDS_BYTES, stream, a); } while (0)
#define OPT(p) ((OPT_MASK >> (p)) & 1)
#if MK_ONE_LAUNCH
    a.ph_lo = 0; a.ph_hi = PH_COUNT;
    void* kargs[] = {&a};
    hipError_t e = hipLaunchCooperativeKernel((const void*)mega, dim3(grid), dim3(NTHREADS), kargs, LDS_BYTES, stream);
    if (e != hipSuccess) fprintf(stderr, "kernel_launch: cooperative launch failed: %s\n", hipGetErrorString(e));
#else
    if (OPT(0)) RUN(PH_PRO, PH_PRO + 1); else k_mod<<<dim3(6 * D / 256, NB + 1), 256, 0, stream>>>(c, c_ctx, mod_w, mod_b, MOD);
    if (OPT(1)) RUN(PH_NORM1, PH_NORM1 + 1);
    else { k_norm1<<<(M + MC) / 4, 256, 0, stream>>>(x, ctx, n1g, MOD, H); k_biasup<<<dim3(F2 / 256, NB), 256, 0, stream>>>(MOD, w_up, BIASUP); }
    if (OPT(2)) RUN(PH_GEMM1, PH_GEMM1 + 1);
    else { k_gemm<EpiIn><<<dim3(PCOLS / 64, M / 64), 256, 0, stream>>>(H, D, w_in, PCOLS, D, EpiIn{AG, P});
           k_gemm<EpiInCtx><<<dim3(SW / 64, MC / 64), 256, 0, stream>>>(H + (size_t)M * D, D, w_in, PCOLS, D, EpiInCtx{AG}); }
    if (OPT(3)) { RUN(PH_SSME, PH_SSME + 1); RUN(PH_SCAN, PH_SCAN + 1); RUN(PH_SSMY, PH_SSMY + 1); }
    else { k_ybr<<<(unsigned)(((size_t)M * SW + 255) / 256), 256, 0, stream>>>(P, sconv_w, YBR);
           k_ssm<<<dim3(NB, NG), 64, 0, stream>>>(AG, lam_re, lam_im, log_dt, b_re, b_im, c_re, c_im, ssm_d, YF, Z); }
    if (OPT(4)) RUN(PH_GLU, PH_GLU + 1); else k_gemm<EpiGluN><<<dim3(SW / 64, M / 64), 256, 0, stream>>>(Z, SW, glu_w, SW, SW, EpiGluN{Z, glu_b, YA});
    if (OPT(5)) RUN(PH_PROJ, PH_PROJ + 1);
    else { k_gemm<EpiProjAN><<<dim3(D / 64, M / 64), 256, 0, stream>>>(YA, SW, proj_a, D, SW, EpiProjAN{P, MG});
           k_gemm<EpiProjBN><<<dim3(D / 64, M / 64), 256, 0, stream>>>(YBR, SW, proj_b, D, SW, EpiProjBN{P, MG}); }
    if (OPT(6)) RUN(PH_OUT, PH_OUT + 1);
    else { k_gemm<EpiOutN><<<dim3(D / 64, M / 64), 256, 0, stream>>>(MG, D, w_out, D, D, EpiOutN{x, MOD, n2g, out, X1S}); k_rowss<<<M / 4, 256, 0, stream>>>(out, SS1); }
    if (OPT(7)) { RUN(PH_UP0, PH_UP0 + 1); RUN(PH_CONV0, PH_CONV0 + 1); RUN(PH_DOWN0UP1, PH_DOWN0UP1 + 1); RUN(PH_CONV1, PH_CONV1 + 1); RUN(PH_DOWN1, PH_DOWN1 + 1); RUN(PH_FINAL, PH_FINAL + 1); }
    else {
        for (int half = 0; half < 2; ++half) { const int row0 = half * HALF_ROWS;
            k_gemm<EpiUpN><<<dim3(F2 / 64, HALF_ROWS / 64), 256, 0, stream>>>(X1S + (size_t)row0 * D, D, w_up, F2, D, EpiUpN{SS1, BIASUP, UP, row0, 0});
            k_conv<<<(unsigned)(((size_t)HALF_ROWS * FH + 255) / 256), 256, 0, stream>>>(UP, conv_w, ACT);
            k_gemm<EpiDownN><<<dim3(D / 64, HALF_ROWS / 64), 256, 0, stream>>>(ACT, FH, w_down, D, FH, EpiDownN{MOD, out, row0, 0}); }
        k_final<<<M / 4, 256, 0, stream>>>(out, final_g);
    }
#endif
}
```

```cpp
#include <hip/hip_runtime.h>
#include <hip/hip_cooperative_groups.h>
#include <stdint.h>
#include <cstdio>
namespace cg = cooperative_groups;

#ifndef MK_ONE_LAUNCH
#define MK_ONE_LAUNCH 1
#endif
#ifndef PROBE_DUP
#define PROBE_DUP 0x0
#endif
#ifndef PROBE_SUB
#define PROBE_SUB 0x0
#endif
#ifndef OPT_MASK
#define OPT_MASK 0xFF
#endif

typedef unsigned short bf16_t;
typedef float f32x4 __attribute__((ext_vector_type(4)));
typedef float f32x2 __attribute__((ext_vector_type(2)));
typedef unsigned u32x4 __attribute__((ext_vector_type(4)));
typedef unsigned u32x2 __attribute__((ext_vector_type(2)));
typedef short bf16x8 __attribute__((ext_vector_type(8)));
#define LAS __attribute__((address_space(3)))

constexpr int D = 1024, NB = 32, SEQ = 2048, CTXL = 256;
constexpr int M = NB * SEQ;
constexpr int MC = NB * CTXL;
constexpr int PCOLS = 4096, SW = 512, NG = 32, GH = 16, PS = 64;
constexpr int FH = 2816, F2 = 5632;
constexpr int TCH = 64;
constexpr int NCL = SEQ / TCH;
constexpr int NCC = CTXL / TCH;
constexpr int AGK = TCH * GH + 4 * PS;
constexpr int AGR = NB * NCL + NB * NCC;
constexpr int PW = PCOLS - SW;
constexpr int HALF_ROWS = M / 2;
constexpr float EPS = 1e-6f;

constexpr size_t MiB = 1ull << 20;
constexpr size_t WS_CTL = 0;
constexpr size_t WS_BAR = 4096;
constexpr size_t WS_ZEROS = 32 * 1024;
constexpr size_t WS_YBRCNT = 33 * 1024;
constexpr size_t WS_MOD = 64 * 1024;
constexpr size_t WS_BIASUP = 1 * MiB;
constexpr size_t WS_SS1 = 2 * MiB;
constexpr size_t WS_SS2 = 2 * MiB + 256 * 1024;
constexpr size_t CTL_ZERO_BYTES = 3 * MiB;
constexpr size_t WS_WIN = 4 * MiB;
constexpr size_t WS_WGLU = 12 * MiB;
constexpr size_t WS_WPA = 13 * MiB;
constexpr size_t WS_WPB = 14 * MiB;
constexpr size_t WS_WOUT = 15 * MiB;
constexpr size_t WS_WUP = 17 * MiB;
constexpr size_t WS_WDOWN = 28 * MiB;
constexpr size_t WS_OP = 34 * MiB;
constexpr size_t WS_WE = 114 * MiB;
constexpr size_t WS_P = 130 * MiB;
constexpr size_t WS_H = 578 * MiB;
constexpr size_t WS_AG = 722 * MiB;
constexpr size_t WS_E = 812 * MiB;
constexpr size_t WS_YBR = 850 * MiB;
constexpr size_t WS_Z = 914 * MiB;
constexpr size_t WS_YA = 578 * MiB;
constexpr size_t WS_MERGED = 722 * MiB;
constexpr size_t WS_X1S = 130 * MiB;
constexpr size_t WS_UP = 258 * MiB;
constexpr size_t WS_ACT = 610 * MiB;
constexpr size_t WS_KT = 1016 * MiB;
constexpr size_t WS_APW = 1020 * MiB;
constexpr size_t WS_NEED = 1024 * MiB;

__device__ __forceinline__ float bf2f(bf16_t v) { return __uint_as_float(((unsigned)v) << 16); }
__device__ __forceinline__ bf16_t f2bf(float f) { unsigned u = __float_as_uint(f); return (bf16_t)((u + 0x7fffu + ((u >> 16) & 1u)) >> 16); }
__device__ __forceinline__ float sigmoidf_(float x) { return 1.f / (1.f + __expf(-x)); }
__device__ __forceinline__ float siluf_(float x) { return x * sigmoidf_(x); }
__device__ __forceinline__ float gelu_tanh(float x) { const float k = 0.7978845608028654f; return 0.5f * x * (1.f + tanhf(k * (x + 0.044715f * x * x * x))); }
__device__ __forceinline__ float wave_sum(float v) {
#pragma unroll
    for (int o = 1; o < 64; o <<= 1) v += __shfl_xor(v, o);
    return v;
}
__device__ __forceinline__ float fsig(float x) { return __builtin_amdgcn_rcpf(1.f + __builtin_amdgcn_exp2f(-1.4426950408889634f * x)); }
__device__ __forceinline__ float fgelu(float x) { const float y = 1.5957691216057308f * (x + 0.044715f * x * x * x); return x * fsig(y); }
__device__ __forceinline__ unsigned cvt_pk_bf16(float lo, float hi) { unsigned r; asm volatile("v_cvt_pk_bf16_f32 %0, %1, %2" : "=v"(r) : "v"(lo), "v"(hi)); return r; }
__device__ __forceinline__ u32x4 pack8(const f32x4 a, const f32x4 b) { u32x4 w; w.x = cvt_pk_bf16(a[0], a[1]); w.y = cvt_pk_bf16(a[2], a[3]); w.z = cvt_pk_bf16(b[0], b[1]); w.w = cvt_pk_bf16(b[2], b[3]); return w; }
__device__ __forceinline__ void unpack8(const u32x4 w, f32x4& a, f32x4& b) {
    a[0] = __uint_as_float(w.x << 16); a[1] = __uint_as_float(w.x & 0xffff0000u); a[2] = __uint_as_float(w.y << 16); a[3] = __uint_as_float(w.y & 0xffff0000u);
    b[0] = __uint_as_float(w.z << 16); b[1] = __uint_as_float(w.z & 0xffff0000u); b[2] = __uint_as_float(w.w << 16); b[3] = __uint_as_float(w.w & 0xffff0000u); }

__device__ __forceinline__ void ssm_disc(float lr, float li, float dt, float& ar, float& ai, float& qr, float& qi) {
    const float ex = expf(lr * dt); float sn, cs; sincosf(li * dt, &sn, &cs);
    ar = ex * cs; ai = ex * sn;
    float sh, chh; sincosf(0.5f * li * dt, &sh, &chh);
    const float xr = expm1f(lr * dt) * cs - 2.f * sh * sh, xi = ex * sn;
    const float den = lr * lr + li * li;
    qr = (xr * lr + xi * li) / den; qi = (xi * lr - xr * li) / den;
}
__device__ __forceinline__ void ssm_apow(float lr, float li, float dt, float k, float& pr, float& pi) {
    const float ex = expf(lr * dt * k); float sn, cs; sincosf(li * dt * k, &sn, &cs); pr = ex * cs; pi = ex * sn;
}

__global__ void k_mod(const float* c, const float* c_ctx, const float* mod_w, const float* mod_b, float* MOD) {
    int n = blockIdx.x * blockDim.x + threadIdx.x; int r = blockIdx.y;
    if (n >= 6 * D) return;
    const float* cond = r < NB ? c + (size_t)r * D : c_ctx;
    float acc = 0.f;
    for (int k = 0; k < D; ++k) acc += siluf_(cond[k]) * mod_w[(size_t)k * 6 * D + n];
    MOD[(size_t)r * 6 * D + n] = acc + mod_b[n];
}
__global__ void k_norm1(const float* x, const float* ctx, const float* g, const float* MOD, bf16_t* H) {
    int row = blockIdx.x * (blockDim.x / 64) + (threadIdx.x >> 6); int lane = threadIdx.x & 63;
    if (row >= M + MC) return;
    const float* xr; int mr;
    if (row < M) { xr = x + (size_t)row * D; mr = row / SEQ; } else { xr = ctx + (size_t)(row - M) * D; mr = NB; }
    const float* sh = MOD + (size_t)mr * 6 * D; const float* sc = sh + D;
    float ss = 0.f;
    for (int k = lane; k < D; k += 64) { float v = xr[k]; ss += v * v; }
    ss = wave_sum(ss);
    float r = rsqrtf(ss / D + EPS);
    for (int k = lane; k < D; k += 64) H[(size_t)row * D + k] = f2bf(xr[k] * r * g[k] * (1.f + sc[k]) + sh[k]);
}
template <class Epi>
__global__ void __launch_bounds__(256) k_gemm(const bf16_t* A, int lda, const float* W, int ldw, int K, Epi epi) {
    __shared__ float As[16][65];
    __shared__ float Ws[16][64];
    const int tx = threadIdx.x & 15, ty = threadIdx.x >> 4;
    const int m0 = blockIdx.y * 64, n0 = blockIdx.x * 64;
    float acc[4][4];
#pragma unroll
    for (int i = 0; i < 4; ++i)
#pragma unroll
        for (int j = 0; j < 4; ++j) acc[i][j] = 0.f;
    for (int k0 = 0; k0 < K; k0 += 16) {
#pragma unroll
        for (int i = 0; i < 4; ++i) { int idx = threadIdx.x + i * 256; int r = idx >> 4, kk = idx & 15; As[kk][r] = bf2f(A[(size_t)(m0 + r) * lda + k0 + kk]); }
#pragma unroll
        for (int i = 0; i < 4; ++i) { int idx = threadIdx.x + i * 256; int kk = idx >> 6, cc = idx & 63; Ws[kk][cc] = W[(size_t)(k0 + kk) * ldw + n0 + cc]; }
        __syncthreads();
#pragma unroll
        for (int kk = 0; kk < 16; ++kk) {
            float a[4], b[4];
#pragma unroll
            for (int i = 0; i < 4; ++i) a[i] = As[kk][ty * 4 + i];
#pragma unroll
            for (int j = 0; j < 4; ++j) b[j] = Ws[kk][tx * 4 + j];
#pragma unroll
            for (int i = 0; i < 4; ++i)
#pragma unroll
                for (int j = 0; j < 4; ++j) acc[i][j] += a[i] * b[j];
        }
        __syncthreads();
    }
#pragma unroll
    for (int i = 0; i < 4; ++i)
#pragma unroll
        for (int j = 0; j < 4; ++j) epi(m0 + ty * 4 + i, n0 + tx * 4 + j, acc[i][j]);
}
struct EpiIn {
    bf16_t* AG; bf16_t* P;
    __device__ void operator()(int m, int n, float v) const {
        if (n < SW) { int b = m / SEQ, t = m % SEQ, g = n / GH, h = n % GH;
            AG[((size_t)g * AGR + b * NCL + t / TCH) * AGK + (t % TCH) * GH + h] = f2bf(v); }
        else P[(size_t)m * PW + (n - SW)] = f2bf(n >= 2048 ? sigmoidf_(v) : v);
    }
};
struct EpiInCtx {
    bf16_t* AG;
    __device__ void operator()(int m, int n, float v) const {
        int b = m / CTXL, t = m % CTXL, g = n / GH, h = n % GH;
        AG[((size_t)g * AGR + NB * NCL + b * NCC + t / TCH) * AGK + (t % TCH) * GH + h] = f2bf(v);
    }
};
struct EpiGluN { const bf16_t* Z; const float* bias; bf16_t* YA;
    __device__ void operator()(int m, int n, float v) const { float z = bf2f(Z[(size_t)m * SW + n]); YA[(size_t)m * SW + n] = f2bf(z * sigmoidf_(v + bias[n])); } };
struct EpiProjAN { const bf16_t* P; bf16_t* MG;
    __device__ void operator()(int m, int n, float v) const { float ga = bf2f(P[(size_t)m * PW + 1536 + n]); MG[(size_t)m * D + n] = f2bf(ga * v); } };
struct EpiProjBN { const bf16_t* P; bf16_t* MG;
    __device__ void operator()(int m, int n, float v) const { float gb = bf2f(P[(size_t)m * PW + 2560 + n]); MG[(size_t)m * D + n] = f2bf(bf2f(MG[(size_t)m * D + n]) + gb * v); } };
struct EpiOutN { const float* x; const float* MOD; const float* n2g; float* X1; bf16_t* X1S;
    __device__ void operator()(int m, int n, float v) const { int b = m / SEQ; const float* md = MOD + (size_t)b * 6 * D;
        float x1 = x[(size_t)m * D + n] + md[2 * D + n] * v; X1[(size_t)m * D + n] = x1;
        X1S[(size_t)m * D + n] = f2bf(x1 * n2g[n] * (1.f + md[4 * D + n])); } };
struct EpiUpN { const float* SS1; const float* BIASUP; bf16_t* UP; int row0; int pad;
    __device__ void operator()(int m, int n, float v) const { int mg = row0 + m; int b = mg / SEQ;
        float r = rsqrtf(SS1[mg] / D + EPS); UP[(size_t)m * F2 + n] = f2bf(v * r + BIASUP[(size_t)b * F2 + n]); } };
struct EpiDownN { const float* MOD; float* X; int row0; int pad;
    __device__ void operator()(int m, int n, float v) const { int mg = row0 + m; int b = mg / SEQ;
        X[(size_t)mg * D + n] += MOD[(size_t)b * 6 * D + 5 * D + n] * v; } };

__global__ void __launch_bounds__(64) k_ssm(const bf16_t* AG, const float* lam_re, const float* lam_im, const float* log_dt,
                                           const float* b_re, const float* b_im, const float* c_re, const float* c_im, const float* dsk,
                                           float* YF, bf16_t* Z) {
    const int b = blockIdx.x, g = blockIdx.y, p = threadIdx.x;
    float* yf = YF + ((size_t)(b * NG + g) * SEQ) * GH;
    for (int dir = 0; dir < 2; ++dir) {
        const float lr = lam_re[(dir * NG + g) * PS + p], li = lam_im[(dir * NG + g) * PS + p];
        const float dt = expf(log_dt[dir * NG + g]);
        float ar, ai, qr, qi; ssm_disc(lr, li, dt, ar, ai, qr, qi);
        float br[GH], bi[GH], cr[GH], ci[GH];
#pragma unroll
        for (int h = 0; h < GH; ++h) {
            const float tr = b_re[(((size_t)dir * NG + g) * PS + p) * GH + h], ti = b_im[(((size_t)dir * NG + g) * PS + p) * GH + h];
            br[h] = qr * tr - qi * ti; bi[h] = qr * ti + qi * tr;
            cr[h] = c_re[(((size_t)dir * NG + g) * GH + h) * PS + p]; ci[h] = c_im[(((size_t)dir * NG + g) * GH + h) * PS + p];
        }
        float sr = 0.f, si = 0.f;
        for (int n = 0; n < CTXL + SEQ; ++n) {
            const bf16_t* up; int t = 0; bool lat;
            if (n < CTXL) { int j = dir == 0 ? n : CTXL - 1 - n; lat = false;
                up = AG + ((size_t)g * AGR + NB * NCL + b * NCC + j / TCH) * AGK + (j % TCH) * GH; }
            else { t = dir == 0 ? n - CTXL : SEQ - 1 - (n - CTXL); lat = true;
                up = AG + ((size_t)g * AGR + b * NCL + t / TCH) * AGK + (t % TCH) * GH; }
            float u[GH];
#pragma unroll
            for (int h = 0; h < GH; ++h) u[h] = bf2f(up[h]);
            float bur = 0.f, bui = 0.f;
#pragma unroll
            for (int h = 0; h < GH; ++h) { bur += br[h] * u[h]; bui += bi[h] * u[h]; }
            const float nr = ar * sr - ai * si + bur, ni = ar * si + ai * sr + bui; sr = nr; si = ni;
            if (lat) {
                float mine = 0.f;
#pragma unroll
                for (int h = 0; h < GH; ++h) { float v = wave_sum(cr[h] * sr - ci[h] * si); if (p == h) mine = v; }
                if (p < GH) {
                    if (dir == 0) yf[(size_t)t * GH + p] = mine;
                    else { float uu = 0.f;
#pragma unroll
                        for (int h = 0; h < GH; ++h) if (p == h) uu = u[h];
                        float y = dsk[g * GH + p] * uu + yf[(size_t)t * GH + p] + mine;
                        Z[((size_t)b * SEQ + t) * SW + g * GH + p] = f2bf(gelu_tanh(y)); }
                }
            }
        }
    }
}
__global__ void k_ybr(const bf16_t* P, const float* sw, bf16_t* YBR) {
    size_t idx = (size_t)blockIdx.x * blockDim.x + threadIdx.x; if (idx >= (size_t)M * SW) return;
    int m = (int)(idx / SW), ch = (int)(idx % SW); int t = m % SEQ;
    float acc = 0.f;
#pragma unroll
    for (int k = 0; k < 3; ++k) { int tt = t + k - 1; if (tt < 0 || tt >= SEQ) continue; size_t mm = (size_t)(m + k - 1);
        acc += sw[k * SW + ch] * bf2f(P[mm * PW + 512 + ch]) * bf2f(P[mm * PW + 1024 + ch]); }
    YBR[idx] = f2bf(bf2f(P[(size_t)m * PW + ch]) * acc);
}
__global__ void k_rowss(const float* X, float* SS) {
    int row = blockIdx.x * (blockDim.x / 64) + (threadIdx.x >> 6); int lane = threadIdx.x & 63; if (row >= M) return;
    float ss = 0.f; for (int k = lane; k < D; k += 64) { float v = X[(size_t)row * D + k]; ss += v * v; }
    ss = wave_sum(ss); if (lane == 0) SS[row] = ss;
}
__global__ void k_biasup(const float* MOD, const float* wup, float* BIASUP) {
    int n = blockIdx.x * blockDim.x + threadIdx.x; int b = blockIdx.y; if (n >= F2) return;
    const float* sh2 = MOD + (size_t)b * 6 * D + 3 * D; float acc = 0.f;
    for (int k = 0; k < D; ++k) acc += sh2[k] * wup[(size_t)k * F2 + n];
    BIASUP[(size_t)b * F2 + n] = acc;
}
__global__ void k_conv(const bf16_t* UP, const float* cw, bf16_t* ACT) {
    size_t idx = (size_t)blockIdx.x * blockDim.x + threadIdx.x; if (idx >= (size_t)HALF_ROWS * FH) return;
    int m = (int)(idx / FH), j = (int)(idx % FH); int t = m % SEQ; int r = t / 64, c = t % 64;
    float a = 0.f, v = 0.f;
#pragma unroll
    for (int ky = 0; ky < 3; ++ky)
#pragma unroll
        for (int kx = 0; kx < 3; ++kx) { int rr = r + ky - 1, cc = c + kx - 1; if (rr < 0 || rr >= 32 || cc < 0 || cc >= 64) continue;
            size_t mm = (size_t)(m + (ky - 1) * 64 + (kx - 1));
            a += cw[(ky * 3 + kx) * F2 + j] * bf2f(UP[mm * F2 + j]); v += cw[(ky * 3 + kx) * F2 + FH + j] * bf2f(UP[mm * F2 + FH + j]); }
    ACT[idx] = f2bf(siluf_(a) * v);
}
__global__ void k_final(float* X, const float* fg) {
    int row = blockIdx.x * (blockDim.x / 64) + (threadIdx.x >> 6); int lane = threadIdx.x & 63; if (row >= M) return;
    float* xr = X + (size_t)row * D; float ss = 0.f;
    for (int k = lane; k < D; k += 64) { float v = xr[k]; ss += v * v; }
    ss = wave_sum(ss); float r = rsqrtf(ss / D + EPS);
    for (int k = lane; k < D; k += 64) xr[k] = xr[k] * r * fg[k];
}

namespace pg8 {
constexpr int BM = 256, BK = 64, HALF = 128, HTB = HALF * BK * 2, STAGE_BYTES = 8 * HTB, NXCD = 8, WGM = 8;
__host__ __device__ __forceinline__ int lds_byte(int r, int c) { const int st = (r >> 4) * 2 + (c >> 5), rr = r & 15, cc = c & 31, ob = rr * 64 + cc * 2; return st * 1024 + (ob ^ (((ob >> 9) & 1) << 5)); }
__host__ __device__ __forceinline__ void stage_rc(int b, int& R, int& C) { const int st = b / 1024, sb = b % 1024, swz = sb ^ (((sb >> 9) & 1) << 5); R = (st >> 1) * 16 + swz / 64; C = (st & 1) * 32 + (swz % 64) / 2; }
__host__ __device__ __forceinline__ int perm32(int rho) { const int n = rho >> 4, i = rho & 15; return 8 * (i >> 2) + 4 * n + (i & 3); }

struct Unit { const char* A; const char* B; int pm, pn, z, rep; };

struct PlainSched {
    const char* A; const char* B; size_t a_tile, b_tile; int nM, nN, nwg, G, c, z, reps = 1;
    __device__ void init(const void* A_, int lda, const void* B_, int ldb, int Mr, int N, int G_, int c_, int z_) {
        A = (const char*)A_; B = (const char*)B_; a_tile = (size_t)BM * lda * 2; b_tile = (size_t)BM * ldb * 2; nM = Mr / BM; nN = N / BM; nwg = nM * nN; G = G_; c = c_; z = z_; }
    __device__ bool next(int i, Unit& u) const {
        long L = (long)i * G + c; if (L >= (long)nwg * reps) return false; L %= nwg;
        int wgid = (int)L; { const int q = nwg / NXCD, r = nwg % NXCD, xcd = wgid % NXCD, off = wgid / NXCD; wgid = (xcd < r ? xcd * (q + 1) : r * (q + 1) + (xcd - r) * q) + off; }
        const int nig = WGM * nN, gid = wgid / nig, fm = gid * WGM, gsz = (nM - fm) < WGM ? (nM - fm) : WGM;
        u.pm = fm + ((wgid % nig) % gsz); u.pn = (wgid % nig) / gsz; u.z = z; u.rep = (int)(((long)i * G + c) / nwg);
        u.A = A + (size_t)u.pm * a_tile; u.B = B + (size_t)u.pn * b_tile; return true;
    }
};
struct BatchSched {
    const char* A; const char* B; size_t a_tile, b_tile, a_z, b_z; int nM, nN, per_z, zpx, gpx, x, j, reps = 1;
    __device__ void init(const void* A_, int lda, size_t a_z_, const void* B_, int ldb, size_t b_z_, int nM_, int nN_, int nZ, int G, int c) {
        A = (const char*)A_; B = (const char*)B_; a_tile = (size_t)BM * lda * 2; b_tile = (size_t)BM * ldb * 2; a_z = a_z_; b_z = b_z_;
        nM = nM_; nN = nN_; per_z = nM_ * nN_; zpx = nZ / NXCD; gpx = G / NXCD; x = c % NXCD; j = c / NXCD; }
    __device__ bool next(int i, Unit& u) const {
        int q = i * gpx + j; if (j >= gpx || q >= zpx * per_z * reps) return false; q %= zpx * per_z;
        const int z = x * zpx + q / per_z, r = q % per_z; u.pm = r % nM; u.pn = r / nM; u.z = z; u.rep = 0;
        u.A = A + (size_t)z * a_z + (size_t)u.pm * a_tile; u.B = B + (size_t)z * b_z + (size_t)u.pn * b_tile; return true;
    }
};

template <class Epi, class Sched>
__device__ __forceinline__ void gemm_phase(LAS unsigned char* lds, const int K, const int lda, const int ldb, const Sched& S, const Epi& E, const int stag_ticks = 0) {
    const int tid = threadIdx.x, wid = __builtin_amdgcn_readfirstlane(tid >> 6), lane = tid & 63, wr = wid >> 2, wc = wid & 3, fr = lane & 15, fq = lane >> 4;
    const int nt = K / BK;
    unsigned voffA[2], voffB[2];
#pragma unroll
    for (int i = 0; i < 2; ++i) { int R, C; stage_rc(tid * 16 + i * 8192, R, C); const int Rb = Epi::PERM ? ((R & ~31) + perm32(R & 31)) : R;
        voffA[i] = (unsigned)(R * lda + C) * 2u; voffB[i] = (unsigned)(Rb * ldb + C) * 2u; }
    const size_t kstep = (size_t)(BK * 2);
    const size_t hstepA = (size_t)HALF * lda * 2, hstepB = (size_t)HALF * ldb * 2;
    const unsigned ldsw = (unsigned)wid * 1024u;
    const int aoff = lds_byte(wr * 64 + fr, fq * 8), boff = lds_byte(wc * 32 + fr, fq * 8);
#define PG8_SA(b, h) (((b) * 2 + (h)) * HTB)
#define PG8_SB(b, h) ((4 + (b) * 2 + (h)) * HTB)
#define PG8_STAGE(bufoff, gbase, voff) do { _Pragma("unroll") for (int _i = 0; _i < 2; ++_i) \
        __builtin_amdgcn_global_load_lds((const unsigned*)((const char*)(gbase) + (voff)[_i]), (LAS unsigned*)(lds + (bufoff) + ldsw + _i * 8192), 16, 0, 0); } while (0)
#define PG8_LDA(dst, b, h) do { _Pragma("unroll") for (int m = 0; m < 4; ++m) _Pragma("unroll") for (int k = 0; k < 2; ++k) dst[m][k] = *(const LAS bf16x8*)(lds + PG8_SA(b, h) + aoff + m * 2048 + k * 1024); } while (0)
#define PG8_LDB(dst, b, h) do { _Pragma("unroll") for (int n = 0; n < 2; ++n) _Pragma("unroll") for (int k = 0; k < 2; ++k) dst[n][k] = *(const LAS bf16x8*)(lds + PG8_SB(b, h) + boff + n * 2048 + k * 1024); } while (0)
#define PG8_MMA(ai, bj, At, Bt) do { __builtin_amdgcn_s_setprio(1); _Pragma("unroll") for (int m = 0; m < 4; ++m) _Pragma("unroll") for (int n = 0; n < 2; ++n) _Pragma("unroll") for (int k = 0; k < 2; ++k) \
        acc[ai][bj][m][n] = __builtin_amdgcn_mfma_f32_16x16x32_bf16(Bt[n][k], At[m][k], acc[ai][bj][m][n], 0, 0, 0); __builtin_amdgcn_s_setprio(0); } while (0)
#define PG8_WAIT_V(n) asm volatile("s_waitcnt vmcnt(" #n ")" ::: "memory")
#define PG8_WAIT_L(n) asm volatile("s_waitcnt lgkmcnt(" #n ")" ::: "memory")
#define PG8_BAR __builtin_amdgcn_s_barrier()
#define PG8_SCHED __builtin_amdgcn_sched_barrier(0)
    Unit cur, nxt; int ui = 0;
    if (!S.next(0, cur)) return;
    if (stag_ticks > 0) { const unsigned long long t0 = __builtin_amdgcn_s_memrealtime(); while ((int)(__builtin_amdgcn_s_memrealtime() - t0) < stag_ticks) __builtin_amdgcn_s_sleep(16); }
    f32x4 acc[2][2][4][2];
#pragma unroll
    for (int a = 0; a < 2; ++a)
#pragma unroll
        for (int b = 0; b < 2; ++b)
#pragma unroll
            for (int m = 0; m < 4; ++m)
#pragma unroll
                for (int n = 0; n < 2; ++n) acc[a][b][m][n] = (f32x4){0.f, 0.f, 0.f, 0.f};
    bf16x8 At[4][2], B0[2][2], B1[2][2];
    const char* cA = cur.A; const char* cB = cur.B;
    PG8_STAGE(PG8_SB(0, 0), cB, voffB); PG8_STAGE(PG8_SB(0, 1), cB + hstepB, voffB); PG8_STAGE(PG8_SA(0, 0), cA, voffA); PG8_STAGE(PG8_SA(0, 1), cA + hstepA, voffA);
    if (wr == 1) PG8_BAR;
    PG8_WAIT_V(2); PG8_BAR;
    PG8_STAGE(PG8_SB(1, 0), cB + kstep, voffB); PG8_STAGE(PG8_SA(1, 0), cA + kstep, voffA); PG8_STAGE(PG8_SB(1, 1), cB + hstepB + kstep, voffB);
    PG8_WAIT_V(6); PG8_BAR;
    for (;;) {
        const bool has_next = S.next(ui + 1, nxt);
        const char* nA = has_next ? nxt.A : cA; const char* nB = has_next ? nxt.B : cB;
        for (int t = 0; t < nt; t += 2) {
            const bool last = (t == nt - 2);
            const char* a1 = cA + (size_t)(t + 1) * kstep;
            const char* a2 = last ? nA : cA + (size_t)(t + 2) * kstep; const char* b2 = last ? nB : cB + (size_t)(t + 2) * kstep;
            const char* a3 = a2 + kstep; const char* b3 = b2 + kstep;
            PG8_LDB(B0, 0, 0); PG8_LDB(B1, 0, 1); PG8_SCHED; PG8_LDA(At, 0, 0); PG8_STAGE(PG8_SA(1, 1), a1 + hstepA, voffA);
            PG8_WAIT_V(8); PG8_WAIT_L(0); PG8_BAR; PG8_MMA(0, 0, At, B0); PG8_MMA(0, 1, At, B1); PG8_BAR; PG8_SCHED;
            PG8_LDA(At, 0, 1); PG8_STAGE(PG8_SB(0, 0), b2, voffB); PG8_STAGE(PG8_SB(0, 1), b2 + hstepB, voffB); PG8_STAGE(PG8_SA(0, 0), a2, voffA);
            PG8_WAIT_V(8); PG8_WAIT_L(0); PG8_BAR; PG8_MMA(1, 0, At, B0); PG8_MMA(1, 1, At, B1); PG8_BAR; PG8_SCHED;
            PG8_LDB(B0, 1, 0); PG8_LDB(B1, 1, 1); PG8_SCHED; PG8_LDA(At, 1, 0); PG8_STAGE(PG8_SA(0, 1), a2 + hstepA, voffA);
            PG8_WAIT_V(8); PG8_WAIT_L(0); PG8_BAR; PG8_MMA(0, 0, At, B0); PG8_MMA(0, 1, At, B1); PG8_BAR; PG8_SCHED;
            PG8_LDA(At, 1, 1); PG8_STAGE(PG8_SB(1, 0), b3, voffB); PG8_STAGE(PG8_SB(1, 1), b3 + hstepB, voffB); PG8_STAGE(PG8_SA(1, 0), a3, voffA);
            PG8_WAIT_V(8); PG8_WAIT_L(0); PG8_BAR; PG8_MMA(1, 0, At, B0); PG8_MMA(1, 1, At, B1); PG8_BAR; PG8_SCHED;
        }
        if (wr == 0) PG8_BAR;
        E(acc, cur, wr, wc, fr, fq);
        if (!has_next) break;
#pragma unroll
        for (int a = 0; a < 2; ++a)
#pragma unroll
            for (int b = 0; b < 2; ++b)
#pragma unroll
                for (int m = 0; m < 4; ++m)
#pragma unroll
                    for (int n = 0; n < 2; ++n) acc[a][b][m][n] = (f32x4){0.f, 0.f, 0.f, 0.f};
        cur = nxt; cA = nA; cB = nB; ++ui;
        if (wr == 1) PG8_BAR;
    }
    PG8_WAIT_V(0);
    PG8_BAR;
#undef PG8_SA
#undef PG8_SB
#undef PG8_STAGE
#undef PG8_LDA
#undef PG8_LDB
#undef PG8_MMA
#undef PG8_WAIT_V
#undef PG8_WAIT_L
#undef PG8_BAR
#undef PG8_SCHED
}
}
using pg8::Unit;

#define EPI_ROWS(...) _Pragma("unroll") for (int ai = 0; ai < 2; ++ai) _Pragma("unroll") for (int m = 0; m < 4; ++m) { const int row = u.pm * 256 + ai * 128 + wr * 64 + m * 16 + fr; __VA_ARGS__ }
#define EPI_COLS(...) _Pragma("unroll") for (int bj = 0; bj < 2; ++bj) { const int col0 = u.pn * 256 + bj * 128 + wc * 32 + 8 * fq; const f32x4 v0 = acc[ai][bj][m][0], v1 = acc[ai][bj][m][1]; __VA_ARGS__ }

struct EpiGemm1 {
    static constexpr bool PERM = true;
    bf16_t* AG; bf16_t* P;
    __device__ __forceinline__ void operator()(const f32x4 (&acc)[2][2][4][2], const Unit& u, int wr, int wc, int fr, int fq) const {
        EPI_ROWS(
            EPI_COLS(
                if (u.pn < 2) {
                    const int g = col0 >> 4, hf = (col0 >> 3) & 1; size_t arow;
                    if (u.z == 0) { const int b = row >> 11, t = row & 2047; arow = (size_t)g * AGR + b * NCL + (t >> 6); }
                    else { const int b = row >> 8, t = row & 255; arow = (size_t)g * AGR + NB * NCL + b * NCC + (t >> 6); }
                    *(u32x4*)(AG + arow * AGK + (row & 63) * GH + hf * 8) = pack8(v0, v1);
                } else {
                    f32x4 a = v0, b = v1;
                    if (u.pn >= 8) {
_Pragma("unroll")
                        for (int e = 0; e < 4; ++e) { a[e] = fsig(a[e]); b[e] = fsig(b[e]); } }
                    *(u32x4*)(P + (size_t)row * PW + (col0 - SW)) = pack8(a, b);
                }
            )
        )
    }
};
struct EpiE {
    static constexpr bool PERM = true;
    float* E;
    __device__ __forceinline__ void operator()(const f32x4 (&acc)[2][2][4][2], const Unit& u, int wr, int wc, int fr, int fq) const {
        EPI_ROWS(
            if (row < AGR) {
                EPI_COLS( float* dst = E + ((size_t)u.z * AGR + row) * 256 + col0; *(f32x4*)dst = v0; *(f32x4*)(dst + 4) = v1; )
            }
        )
    }
};
struct EpiY {
    static constexpr bool PERM = true;
    bf16_t* Z;
    __device__ __forceinline__ void operator()(const f32x4 (&acc)[2][2][4][2], const Unit& u, int wr, int wc, int fr, int fq) const {
        EPI_ROWS(
            const int b = row >> 5; const int c = row & 31;
            EPI_COLS(
                const int i = col0 >> 4, hf = (col0 >> 3) & 1; f32x4 a, bb;
_Pragma("unroll")
                for (int e = 0; e < 4; ++e) { a[e] = fgelu(v0[e]); bb[e] = fgelu(v1[e]); }
                *(u32x4*)(Z + ((size_t)b * SEQ + c * TCH + i) * SW + u.z * GH + hf * 8) = pack8(a, bb);
            )
        )
    }
};
struct EpiGlu {
    static constexpr bool PERM = true;
    const bf16_t* Z; const float* bias; bf16_t* YA;
    __device__ __forceinline__ void operator()(const f32x4 (&acc)[2][2][4][2], const Unit& u, int wr, int wc, int fr, int fq) const {
        f32x4 bv[2][2];
#pragma unroll
        for (int bj = 0; bj < 2; ++bj) { const int col0 = u.pn * 256 + bj * 128 + wc * 32 + 8 * fq; bv[bj][0] = *(const f32x4*)(bias + col0); bv[bj][1] = *(const f32x4*)(bias + col0 + 4); }
        EPI_ROWS(
            EPI_COLS(
                const u32x4 zw = *(const u32x4*)(Z + (size_t)row * SW + col0); f32x4 z0, z1; unpack8(zw, z0, z1); f32x4 a, b;
_Pragma("unroll")
                for (int e = 0; e < 4; ++e) { a[e] = z0[e] * fsig(v0[e] + bv[bj][0][e]); b[e] = z1[e] * fsig(v1[e] + bv[bj][1][e]); }
                *(u32x4*)(YA + (size_t)row * SW + col0) = pack8(a, b);
            )
            if (m & 1) asm volatile("" ::: "memory");
        )
    }
};
template <bool SECOND> struct EpiProj {
    static constexpr bool PERM = true;
    const bf16_t* P; bf16_t* MG;
    __device__ __forceinline__ void operator()(const f32x4 (&acc)[2][2][4][2], const Unit& u, int wr, int wc, int fr, int fq) const {
        EPI_ROWS(
            EPI_COLS(
                const u32x4 gw = *(const u32x4*)(P + (size_t)row * PW + (SECOND ? 2560 : 1536) + col0); f32x4 g0, g1; unpack8(gw, g0, g1);
                f32x4 a = g0 * v0, b = g1 * v1;
                if (SECOND) { const u32x4 ow = *(const u32x4*)(MG + (size_t)row * D + col0); f32x4 o0, o1; unpack8(ow, o0, o1); a += o0; b += o1; }
                *(u32x4*)(MG + (size_t)row * D + col0) = pack8(a, b);
            )
            if (m & 1) asm volatile("" ::: "memory");
        )
    }
};
struct EpiOut {
    static constexpr bool PERM = true;
    const float* x; const float* MOD; const float* n2g; float* X1; bf16_t* X1S; float* SS1;
    __device__ __forceinline__ void operator()(const f32x4 (&acc)[2][2][4][2], const Unit& u, int wr, int wc, int fr, int fq) const {
        const float* md = MOD + (size_t)(u.pm >> 3) * 6 * D;
        f32x4 g1v[2][2], fac[2][2];
#pragma unroll
        for (int bj = 0; bj < 2; ++bj)
#pragma unroll
            for (int n = 0; n < 2; ++n) { const int col = u.pn * 256 + bj * 128 + wc * 32 + 8 * fq + 4 * n;
                g1v[bj][n] = *(const f32x4*)(md + 2 * D + col); fac[bj][n] = *(const f32x4*)(n2g + col) * (*(const f32x4*)(md + 4 * D + col) + 1.f); }
        EPI_ROWS(
            float ss = 0.f;
            EPI_COLS(
                const size_t off = (size_t)row * D + col0;
                const f32x4 a = *(const f32x4*)(x + off) + g1v[bj][0] * v0, b = *(const f32x4*)(x + off + 4) + g1v[bj][1] * v1;
                *(f32x4*)(X1 + off) = a; *(f32x4*)(X1 + off + 4) = b;
                ss += (a[0] * a[0] + a[1] * a[1]) + (a[2] * a[2] + a[3] * a[3]) + (b[0] * b[0] + b[1] * b[1]) + (b[2] * b[2] + b[3] * b[3]);
                *(u32x4*)(X1S + off) = pack8(a * fac[bj][0], b * fac[bj][1]);
            )
            ss += __shfl_xor(ss, 16); ss += __shfl_xor(ss, 32);
            if (fq == 0 && u.rep == 0) unsafeAtomicAdd(SS1 + row, ss);
            if (m & 1) asm volatile("" ::: "memory");
        )
    }
};
struct EpiUp {
    static constexpr bool PERM = true;
    const float* SS1; const float* BIASUP; bf16_t* UP; int row0;
    __device__ __forceinline__ void operator()(const f32x4 (&acc)[2][2][4][2], const Unit& u, int wr, int wc, int fr, int fq) const {
        const float* bu = BIASUP + (size_t)((row0 >> 11) + (u.pm >> 3)) * F2;
        f32x4 bv[2][2];
#pragma unroll
        for (int bj = 0; bj < 2; ++bj) { const int col0 = u.pn * 256 + bj * 128 + wc * 32 + 8 * fq; bv[bj][0] = *(const f32x4*)(bu + col0); bv[bj][1] = *(const f32x4*)(bu + col0 + 4); }
        EPI_ROWS(
            const float rs = rsqrtf(SS1[row0 + row] * (1.f / D) + EPS);
            EPI_COLS( *(u32x4*)(UP + (size_t)row * F2 + col0) = pack8(v0 * rs + bv[bj][0], v1 * rs + bv[bj][1]); )
        )
    }
};
struct EpiDown {
    static constexpr bool PERM = true;
    const float* MOD; float* X; float* SS2; int row0;
    __device__ __forceinline__ void operator()(const f32x4 (&acc)[2][2][4][2], const Unit& u, int wr, int wc, int fr, int fq) const {
        const float* md = MOD + (size_t)((row0 >> 11) + (u.pm >> 3)) * 6 * D + 5 * D;
        f32x4 g2v[2][2];
#pragma unroll
        for (int bj = 0; bj < 2; ++bj) { const int col0 = u.pn * 256 + bj * 128 + wc * 32 + 8 * fq; g2v[bj][0] = *(const f32x4*)(md + col0); g2v[bj][1] = *(const f32x4*)(md + col0 + 4); }
        EPI_ROWS(
            float ss = 0.f;
            EPI_COLS(
                const size_t off = (size_t)(row0 + row) * D + col0;
                const f32x4 a = *(const f32x4*)(X + off) + g2v[bj][0] * v0, b = *(const f32x4*)(X + off + 4) + g2v[bj][1] * v1;
                *(f32x4*)(X + off) = a; *(f32x4*)(X + off + 4) = b;
                ss += (a[0] * a[0] + a[1] * a[1]) + (a[2] * a[2] + a[3] * a[3]) + (b[0] * b[0] + b[1] * b[1]) + (b[2] * b[2] + b[3] * b[3]);
            )
            ss += __shfl_xor(ss, 16); ss += __shfl_xor(ss, 32);
            if (fq == 0) unsafeAtomicAdd(SS2 + row0 + row, ss);
            if (m & 1) asm volatile("" ::: "memory");
        )
    }
};

constexpr int NWAVES = 8, NTHREADS = 512;
#ifndef STAG_K1024
#define STAG_K1024 800
#endif
constexpr int LDS_BYTES = 147456;
#define LDS_WAIT() asm volatile("s_waitcnt lgkmcnt(0)" ::: "memory")


#define XB_TMO      128
#define XB_XCNT(j)  (256  + 64 * (j))
#define XB_XSUB(j)  (1280 + 64 * (j))
#define XB_XGEN(j)  (2304 + 64 * (j))
#define XB_TOP      3328
#define XB_TOPGEN   3392
#define XCD_BAR_WORDS 3456
#define XB_SPIN_CAP (1u << 18)
__device__ __forceinline__ unsigned xb_ld(unsigned* p)              { return __hip_atomic_load(p, __ATOMIC_RELAXED, __HIP_MEMORY_SCOPE_AGENT); }
__device__ __forceinline__ unsigned xb_add(unsigned* p, unsigned v) { return __hip_atomic_fetch_add(p, v, __ATOMIC_RELAXED, __HIP_MEMORY_SCOPE_AGENT); }
__device__ __forceinline__ unsigned xb_xcc_id() { return (unsigned)__builtin_amdgcn_s_getreg((3 << 11) | 20) & 0xFu; }
#define XB_SPIN(cond, bar) do { unsigned _sp = 0; while (cond) { __builtin_amdgcn_s_sleep(1); \
    if ((++_sp & 255u) == 0u) { if (xb_ld(&(bar)[XB_TMO])) break; if (_sp > XB_SPIN_CAP) { atomicAdd(&(bar)[XB_TMO], 1u); break; } } } } while (0)
struct XcdBarrier { unsigned* bar; unsigned x; volatile LAS unsigned* st; };
__device__ __forceinline__ XcdBarrier xcd_barrier_post(unsigned* bar, volatile LAS unsigned* st) {
    XcdBarrier b; b.bar = bar; b.x = xb_xcc_id(); b.st = st;
    if (threadIdx.x == 0) (void)xb_add(&bar[XB_XCNT(b.x)], 1u);
    return b;
}
__device__ __forceinline__ void xcd_barrier_complete(unsigned* bar, unsigned x, unsigned& nloc, unsigned& nx) {
    const unsigned G = gridDim.x * gridDim.y * gridDim.z;
    unsigned sum, cnt, mine, sp = 0u;
    for (;;) {
        sum = 0u; cnt = 0u; mine = 0u;
#pragma unroll
        for (unsigned j = 0; j < 16; ++j) { const unsigned c = xb_ld(&bar[XB_XCNT(j)]); sum += c; cnt += (c > 0u) ? 1u : 0u; mine = (j == x) ? c : mine; }
        if (sum == G) break;
        __builtin_amdgcn_s_sleep(1);
        if ((++sp & 255u) == 0u) { if (xb_ld(&bar[XB_TMO])) break; if (sp > XB_SPIN_CAP) { atomicAdd(&bar[XB_TMO], 1u); break; } }
    }
    nloc = mine > 0u ? mine : 1u; nx = cnt > 0u ? cnt : 1u;
}
__device__ __forceinline__ void xcd_barrier(const XcdBarrier& b) {
    asm volatile("s_waitcnt vmcnt(0)" ::: "memory");
    __syncthreads();
    if (threadIdx.x == 0) {
        unsigned* bar = b.bar;
        __builtin_amdgcn_s_waitcnt(0);
        unsigned nloc = b.st[0], nx = b.st[1];
        if (nloc == 0u) { xcd_barrier_complete(bar, b.x, nloc, nx); b.st[0] = nloc; b.st[1] = nx; }
        const unsigned old = xb_add(&bar[XB_XSUB(b.x)], 1u);
        const unsigned gen = old / nloc;
        if (old + 1u == (gen + 1u) * nloc) {
            __builtin_amdgcn_fence(__ATOMIC_RELEASE, "agent");
            asm volatile("s_waitcnt vmcnt(0)" ::: "memory");
            const unsigned og = xb_add(&bar[XB_TOP], 1u);
            const unsigned tg = og / nx;
            if (og + 1u == (tg + 1u) * nx) xb_add(&bar[XB_TOPGEN], 1u);
            else XB_SPIN(xb_ld(&bar[XB_TOPGEN]) == tg, bar);
            __builtin_amdgcn_fence(__ATOMIC_ACQUIRE, "agent");
            xb_add(&bar[XB_XGEN(b.x)], 1u);
            asm volatile("s_waitcnt vmcnt(0)" ::: "memory");
        } else {
            XB_SPIN(xb_ld(&bar[XB_XGEN(b.x)]) == gen, bar);
            __builtin_amdgcn_fence(__ATOMIC_ACQUIRE, "agent");
            asm volatile("s_waitcnt vmcnt(0)" ::: "memory");
        }
    }
    __syncthreads();
}

enum Phase { PH_PRO = 0, PH_NORM1, PH_GEMM1, PH_SSME, PH_SCAN, PH_SSMY, PH_GLU, PH_PROJ, PH_OUT, PH_UP0, PH_CONV0, PH_DOWN0UP1, PH_CONV1, PH_DOWN1, PH_FINAL, PH_COUNT };

struct Args { const float* in[27]; float* out; unsigned char* ws; int ph_lo, ph_hi; };

__device__ __forceinline__ void transpose_item(const float* W, int K, int N, bf16_t* WT, LAS float* scr, int item, int lane) {
    const int nblk = N / 32, kb = item / nblk, nb = item % nblk, k0 = 64 * kb, n0 = 32 * nb;
#pragma unroll
    for (int i = 0; i < 32; ++i) { const int kk = 2 * i + (lane >> 5); scr[kk * 33 + (lane & 31)] = W[(size_t)(k0 + kk) * N + n0 + (lane & 31)]; }
    LDS_WAIT(); asm volatile("" ::: "memory");
    const int c = lane & 7;
#pragma unroll
    for (int j = 0; j < 4; ++j) { const int n = (lane >> 3) + 8 * j; const LAS float* s = scr + (8 * c) * 33 + n;
        u32x4 o; o.x = cvt_pk_bf16(s[0 * 33], s[1 * 33]); o.y = cvt_pk_bf16(s[2 * 33], s[3 * 33]); o.z = cvt_pk_bf16(s[4 * 33], s[5 * 33]); o.w = cvt_pk_bf16(s[6 * 33], s[7 * 33]);
        *(u32x4*)(WT + (size_t)(n0 + n) * K + k0 + 8 * c) = o; }
    LDS_WAIT(); asm volatile("" ::: "memory");
}
template <int R, bool SILU, class RowPtr>
__device__ __forceinline__ void gemv_task(LAS float* scr, const RowPtr& rp, const float* W, int ldw, int n0, int k0, int nk, float* OUT, int ldo, const float* bias, int lane) {
    float acc[R];
#pragma unroll
    for (int r = 0; r < R; ++r) acc[r] = 0.f;
    const int n = n0 + lane;
    for (int ks = 0; ks < nk; ks += 64) {
#pragma unroll
        for (int r = 0; r < R; ++r) { float v = rp(r)[k0 + ks + lane]; if (SILU) v = v * fsig(v); scr[lane * 36 + r] = v; }
        LDS_WAIT(); asm volatile("" ::: "memory");
#pragma unroll 1
        for (int kh = 0; kh < 64; kh += 32) { float w[32];
#pragma unroll
            for (int kk = 0; kk < 32; ++kk) w[kk] = W[(size_t)(k0 + ks + kh + kk) * ldw + n];
#pragma unroll
            for (int kk = 0; kk < 32; ++kk) {
#pragma unroll
                for (int r = 0; r < R; ++r) acc[r] += scr[(kh + kk) * 36 + r] * w[kk]; } }
        LDS_WAIT(); asm volatile("" ::: "memory");
    }
    const float bz = (bias && k0 == 0) ? bias[n] : 0.f;
#pragma unroll
    for (int r = 0; r < R; ++r) unsafeAtomicAdd(OUT + (size_t)r * ldo + n, acc[r] + bz);
}
struct ModRows { const float* c; const float* c_ctx; __device__ __forceinline__ const float* operator()(int r) const { return r < NB ? c + (size_t)r * D : c_ctx; } };
struct Sh2Rows { const float* MOD; __device__ __forceinline__ const float* operator()(int r) const { return MOD + (size_t)r * 6 * D + 3 * D; } };


__device__ __forceinline__ f32x4 cvt4(const u32x2 u) { return (f32x4){__uint_as_float(u.x << 16), __uint_as_float(u.x & 0xffff0000u), __uint_as_float(u.y << 16), __uint_as_float(u.y & 0xffff0000u)}; }
__device__ __forceinline__ void conv_phase(LAS unsigned char* wl, const bf16_t* UP, const float* conv_w, bf16_t* ACT, const unsigned char* zeros, int vw, int NGW, int lane) {
    constexpr int SLOT = 2048, NSLOT = 8, NTASK = (HALF_ROWS / SEQ) * 88 * 8;
    const int q = lane & 7, tk = lane >> 3;
    const unsigned char* upb = (const unsigned char*)UP;
    for (int task = vw; task < NTASK; task += NGW) {
        const int strip = task & 7, slab = (task >> 3) % 88, b = task / 704, c0 = strip * 8, ch0 = slab * 32;
        f32x4 wa[9], wv[9];
#pragma unroll
        for (int k = 0; k < 9; ++k) { wa[k] = *(const f32x4*)(conv_w + k * F2 + ch0 + q * 4); wv[k] = *(const f32x4*)(conv_w + k * F2 + FH + ch0 + q * 4); }
        unsigned off[2]; bool ok[2]; unsigned zoff[2];
#pragma unroll
        for (int i = 0; i < 2; ++i) { const int e = i * 64 + lane, part = e / 40, tok = (e % 40) >> 2, pc = e & 3, col = c0 - 1 + tok;
            ok[i] = (e < 80) && col >= 0 && col < 64; zoff[i] = (unsigned)pc * 16u;
            off[i] = (unsigned)((((size_t)b * SEQ + col) * F2 + (size_t)part * FH + ch0) * 2 + pc * 16); }
#define CONV_ISSUE(s_) do { const int s__ = (s_); const int r__ = s__ - 1; const bool rok = (r__ >= 0) && (r__ < 32); const int sl__ = s__ & (NSLOT - 1); \
        _Pragma("unroll") for (int i = 0; i < 2; ++i) { const unsigned char* src = (rok && ok[i]) ? upb + off[i] + (size_t)r__ * (64 * F2 * 2) : zeros + zoff[i]; \
            __builtin_amdgcn_global_load_lds((const unsigned*)src, (LAS unsigned*)(wl + sl__ * SLOT + i * 1024), 16, 0, 0); } } while (0)
#define CONV_LOADROW(w_, s_) do { const LAS unsigned char* p0 = wl + ((s_) & (NSLOT - 1)) * SLOT + tk * 64 + q * 8; \
        _Pragma("unroll") for (int kx = 0; kx < 3; ++kx) { WA[w_][kx] = cvt4(*(const LAS u32x2*)(p0 + kx * 64)); WV[w_][kx] = cvt4(*(const LAS u32x2*)(p0 + kx * 64 + 640)); } } while (0)
#define CONV_STEP(r_, m_, c_, p_) do { const int r = (r_); \
        if (r <= 27) asm volatile("s_waitcnt vmcnt(8)" ::: "memory"); else if (r == 28) asm volatile("s_waitcnt vmcnt(6)" ::: "memory"); else if (r == 29) asm volatile("s_waitcnt vmcnt(4)" ::: "memory"); \
        else if (r == 30) asm volatile("s_waitcnt vmcnt(2)" ::: "memory"); else asm volatile("s_waitcnt vmcnt(0)" ::: "memory"); \
        CONV_LOADROW(p_, r + 2); \
        f32x4 sa = {0.f, 0.f, 0.f, 0.f}, sv = {0.f, 0.f, 0.f, 0.f}; \
        _Pragma("unroll") for (int kx = 0; kx < 3; ++kx) { sa += wa[kx] * WA[m_][kx]; sv += wv[kx] * WV[m_][kx]; sa += wa[3 + kx] * WA[c_][kx]; sv += wv[3 + kx] * WV[c_][kx]; sa += wa[6 + kx] * WA[p_][kx]; sv += wv[6 + kx] * WV[p_][kx]; } \
        f32x4 o; _Pragma("unroll") for (int e = 0; e < 4; ++e) o[e] = sa[e] * fsig(sa[e]) * sv[e]; \
        u32x2 w; w.x = cvt_pk_bf16(o[0], o[1]); w.y = cvt_pk_bf16(o[2], o[3]); \
        *(u32x2*)(ACT + ((size_t)b * SEQ + r * 64 + c0 + tk) * FH + ch0 + q * 4) = w; \
        asm volatile("s_waitcnt lgkmcnt(0)" ::: "memory"); \
        if (r + 7 < 34) CONV_ISSUE(r + 7); } while (0)
        asm volatile("s_waitcnt lgkmcnt(0)" ::: "memory");
#pragma unroll 1
        for (int s0 = 0; s0 < 7; ++s0) CONV_ISSUE(s0);
        f32x4 WA[3][3], WV[3][3];
        asm volatile("s_waitcnt vmcnt(10)" ::: "memory");
        CONV_LOADROW(0, 0); CONV_LOADROW(1, 1);
#pragma unroll 1
        for (int r3 = 0; r3 < 33; r3 += 3) {
            CONV_STEP(r3, 0, 1, 2);
            if (r3 + 1 < 32) CONV_STEP(r3 + 1, 1, 2, 0);
            if (r3 + 2 < 32) CONV_STEP(r3 + 2, 2, 0, 1);
        }
#undef CONV_ISSUE
#undef CONV_LOADROW
#undef CONV_STEP
    }
}

__global__ void __launch_bounds__(NTHREADS, 2) mega(Args a) {
    extern __shared__ __attribute__((aligned(16))) unsigned char lds_raw[];
    LAS unsigned char* lds = (LAS unsigned char*)lds_raw;
    cg::grid_group grid = cg::this_grid();
    const int tid = threadIdx.x, lane = tid & 63, wave = __builtin_amdgcn_readfirstlane(tid >> 6);
    const int G = gridDim.x, bx = blockIdx.x;
    const int gw = bx * NWAVES + wave, NGW = G * NWAVES;
    const int gt = bx * NTHREADS + tid, NGT = G * NTHREADS;
    const int stag = (((bx / 8) & 1) ? 1 : 0);
    const int vgw = ((bx % 8) * (G / 8) + bx / 8) * NWAVES + wave;
    unsigned char* ws = a.ws;
    const float* x = a.in[0]; const float* cvec = a.in[1]; const float* ctx = a.in[2]; const float* c_ctx = a.in[3];
    const float* mod_w = a.in[4]; const float* mod_b = a.in[5]; const float* n1g = a.in[6]; const float* n2g = a.in[7];
    const float* w_in = a.in[8]; const float* lam_re = a.in[9]; const float* lam_im = a.in[10]; const float* log_dt = a.in[11];
    const float* b_re = a.in[12]; const float* b_im = a.in[13]; const float* c_re = a.in[14]; const float* c_im = a.in[15];
    const float* ssm_d = a.in[16]; const float* glu_w = a.in[17]; const float* glu_b = a.in[18]; const float* sconv_w = a.in[19];
    const float* proj_a = a.in[20]; const float* proj_b = a.in[21]; const float* w_out = a.in[22]; const float* w_up = a.in[23];
    const float* conv_w = a.in[24]; const float* w_down = a.in[25]; const float* final_g = a.in[26];
    float* out = a.out;
    float* MOD = (float*)(ws + WS_MOD); float* BIASUP = (float*)(ws + WS_BIASUP); float* SS1 = (float*)(ws + WS_SS1); float* SS2 = (float*)(ws + WS_SS2);
    bf16_t* WIN = (bf16_t*)(ws + WS_WIN); bf16_t* WGLU = (bf16_t*)(ws + WS_WGLU); bf16_t* WPA = (bf16_t*)(ws + WS_WPA); bf16_t* WPB = (bf16_t*)(ws + WS_WPB);
    bf16_t* WOUT = (bf16_t*)(ws + WS_WOUT); bf16_t* WUP = (bf16_t*)(ws + WS_WUP); bf16_t* WDOWN = (bf16_t*)(ws + WS_WDOWN);
    bf16_t* OP = (bf16_t*)(ws + WS_OP); bf16_t* WE = (bf16_t*)(ws + WS_WE);
    bf16_t* P = (bf16_t*)(ws + WS_P); bf16_t* H = (bf16_t*)(ws + WS_H); bf16_t* AG = (bf16_t*)(ws + WS_AG); float* E = (float*)(ws + WS_E);
    bf16_t* YBR = (bf16_t*)(ws + WS_YBR); bf16_t* Z = (bf16_t*)(ws + WS_Z); bf16_t* YA = (bf16_t*)(ws + WS_YA); bf16_t* MG = (bf16_t*)(ws + WS_MERGED);
    bf16_t* X1S = (bf16_t*)(ws + WS_X1S); bf16_t* UP = (bf16_t*)(ws + WS_UP); bf16_t* ACT = (bf16_t*)(ws + WS_ACT);
    float* KT = (float*)(ws + WS_KT); f32x2* APW = (f32x2*)(ws + WS_APW);
    LAS float* wscr = (LAS float*)(lds + wave * 16384);

    { volatile LAS unsigned* misc = (volatile LAS unsigned*)(lds + 131072 + 256); if (tid < 8) misc[tid] = 0u; }
    __syncthreads();
    const XcdBarrier xbar = xcd_barrier_post((unsigned*)(ws + WS_BAR), (volatile LAS unsigned*)(lds + 131072 + 256));
    const int lo = a.ph_lo, hi = a.ph_hi;
#define IN(k) (lo <= (k) && (k) < hi)
#define REPS(k) (((PROBE_DUP >> (k)) & 1) ? 2 : 1)
#define SUBREPS(k) (((PROBE_SUB >> (k)) & 1) ? 2 : 1)
#ifndef CG_SEAM_MASK
#define CG_SEAM_MASK 0x1
#endif
#define SEAM(k) do { if (IN(k) && IN((k) + 1)) { if ((CG_SEAM_MASK >> (k)) & 1) grid.sync(); else xcd_barrier(xbar); } } while (0)

    if (IN(PH_PRO)) for (int rep = 0; rep < REPS(PH_PRO); ++rep) {
        if (rep) __syncthreads();
        for (int sr_ = 0; sr_ < SUBREPS(0); ++sr_) {
        for (int i = gt; i < NG * 2 * 65 * PS; i += NGT) {
            const int p = i & 63, e = (i >> 6) % 65, gd = i / (65 * 64), dir = gd & 1, g = gd >> 1;
            const float dt = expf(log_dt[dir * NG + g]); float pr, pi;
            ssm_apow(lam_re[(dir * NG + g) * PS + p], lam_im[(dir * NG + g) * PS + p], dt, (float)e, pr, pi);
            APW[i] = (f32x2){pr, pi};
        }
        for (int task = bx; task < NG * 8; task += G) {
            const int g = task >> 3, ts = task & 7;
            LAS f32x2* s_apw = (LAS f32x2*)lds;
            LAS f32x2* s_bb = (LAS f32x2*)(lds + 8192);
            LAS f32x2* s_cc = (LAS f32x2*)(lds + 8192 + 16384);
            for (int i = tid; i < 1024; i += NTHREADS) { const int dir = i >> 9, tt = (i >> 6) & 7, p = i & 63; const float dt = expf(log_dt[dir * NG + g]); float pr, pi;
                ssm_apow(lam_re[(dir * NG + g) * PS + p], lam_im[(dir * NG + g) * PS + p], dt, (float)(ts * 8 + tt), pr, pi); s_apw[i] = (f32x2){pr, pi}; }
            for (int i = tid; i < 2048; i += NTHREADS) { const int dir = i >> 10, p = (i >> 4) & 63, hp = i & 15; const float dt = expf(log_dt[dir * NG + g]); float ar, ai, qr, qi;
                ssm_disc(lam_re[(dir * NG + g) * PS + p], lam_im[(dir * NG + g) * PS + p], dt, ar, ai, qr, qi);
                const size_t bi = (((size_t)dir * NG + g) * PS + p) * GH + hp; const float tr = b_re[bi], ti = b_im[bi];
                s_bb[i] = (f32x2){qr * tr - qi * ti, qr * ti + qi * tr}; }
            for (int i = tid; i < 2048; i += NTHREADS) { const int dir = i >> 10, h = (i >> 6) & 15, p = i & 63; const size_t ci = (((size_t)dir * NG + g) * GH + h) * PS + p;
                s_cc[i] = (f32x2){c_re[ci], c_im[ci]}; }
            __syncthreads();
#pragma unroll 1
            for (int e = 0; e < 8; ++e) { const int o = tid + NTHREADS * e; const int dir = o >> 11, h = (o >> 7) & 15, tt = (o >> 4) & 7, hp = o & 15;
                float s = 0.f;
#pragma unroll 8
                for (int p = 0; p < PS; ++p) { const f32x2 cc = s_cc[(dir * 16 + h) * 64 + p], aw = s_apw[(dir * 8 + tt) * 64 + p], bb = s_bb[(dir * 64 + p) * 16 + hp];
                    const float car = cc.x * aw.x - cc.y * aw.y, cai = cc.x * aw.y + cc.y * aw.x; s += car * bb.x - cai * bb.y; }
                KT[((((size_t)g * 2 + dir) * 16 + h) * 64 + ts * 8 + tt) * 16 + hp] = s; }
            __syncthreads();
        }
        }
        for (int sr_ = 0; sr_ < SUBREPS(1); ++sr_) {
            constexpr int I_IN = (D / 64) * (PCOLS / 32), I_GLU = (SW / 64) * (SW / 32), I_PA = (SW / 64) * (D / 32), I_OUT = (D / 64) * (D / 32), I_UP = (D / 64) * (F2 / 32), I_DN = (FH / 64) * (D / 32);
            constexpr int NITEMS = I_IN + I_GLU + 2 * I_PA + I_OUT + I_UP + I_DN;
            for (int it = gw; it < NITEMS; it += NGW) {
                int r = it;
                if (r < I_IN) { transpose_item(w_in, D, PCOLS, WIN, wscr, r, lane); continue; } r -= I_IN;
                if (r < I_GLU) { transpose_item(glu_w, SW, SW, WGLU, wscr, r, lane); continue; } r -= I_GLU;
                if (r < I_PA) { transpose_item(proj_a, SW, D, WPA, wscr, r, lane); continue; } r -= I_PA;
                if (r < I_PA) { transpose_item(proj_b, SW, D, WPB, wscr, r, lane); continue; } r -= I_PA;
                if (r < I_OUT) { transpose_item(w_out, D, D, WOUT, wscr, r, lane); continue; } r -= I_OUT;
                if (r < I_UP) { transpose_item(w_up, D, F2, WUP, wscr, r, lane); continue; } r -= I_UP;
                transpose_item(w_down, FH, D, WDOWN, wscr, r, lane);
            }
        }
        if (rep == 0) for (int sr_ = 0; sr_ < SUBREPS(5); ++sr_) {
            const ModRows rp{cvec, c_ctx};
            for (int task = NGW - 1 - gw; task < (6 * D / 64) * 16; task += NGW) { const int cb = task >> 4, ks = task & 15;
                gemv_task<NB + 1, true>(wscr, rp, mod_w, 6 * D, cb * 64, ks * 64, 64, sr_ ? (float*)(ws + WS_E) : MOD, 6 * D, mod_b, lane); }
        }
    }
    SEAM(PH_PRO);

    if (IN(PH_NORM1)) for (int rep = 0; rep < REPS(PH_NORM1); ++rep) {
        for (int sr_ = 0; sr_ < SUBREPS(2); ++sr_)
        for (int task = gw; task < NG * 256; task += NGW) {
            const int g = task >> 8, n = task & 255, dir = n >> 7, ri = (n >> 6) & 1, p = n & 63;
            const int j = lane, e = dir ? j : 63 - j;
            const f32x2 pw = APW[(((size_t)g * 2 + dir) * 65 + e) * 64 + p];
            const float dt = expf(log_dt[dir * NG + g]); float ar, ai, qr, qi;
            ssm_disc(lam_re[(dir * NG + g) * PS + p], lam_im[(dir * NG + g) * PS + p], dt, ar, ai, qr, qi);
            const float wr_ = pw.x * qr - pw.y * qi, wi_ = pw.x * qi + pw.y * qr;
            const float* br = b_re + (((size_t)dir * NG + g) * PS + p) * GH; const float* bi = b_im + (((size_t)dir * NG + g) * PS + p) * GH;
            float v[16];
#pragma unroll
            for (int hp = 0; hp < 16; ++hp) v[hp] = ri ? (wr_ * bi[hp] + wi_ * br[hp]) : (wr_ * br[hp] - wi_ * bi[hp]);
            bf16_t* dst = WE + ((size_t)g * 256 + n) * 1024 + j * 16;
            u32x4 w0, w1; w0.x = cvt_pk_bf16(v[0], v[1]); w0.y = cvt_pk_bf16(v[2], v[3]); w0.z = cvt_pk_bf16(v[4], v[5]); w0.w = cvt_pk_bf16(v[6], v[7]);
            w1.x = cvt_pk_bf16(v[8], v[9]); w1.y = cvt_pk_bf16(v[10], v[11]); w1.z = cvt_pk_bf16(v[12], v[13]); w1.w = cvt_pk_bf16(v[14], v[15]);
            *(u32x4*)dst = w0; *(u32x4*)(dst + 8) = w1;
        }
        for (int sr_ = 0; sr_ < SUBREPS(3); ++sr_)
        for (int task = gw; task < NG * 1024; task += NGW) {
            const int g = task >> 10, n = task & 1023, i = n >> 4, h = n & 15;
            bf16_t* dst = OP + ((size_t)g * 1024 + n) * AGK;
            const float* kt0 = KT + (((size_t)g * 2 + 0) * 16 + h) * 1024; const float* kt1 = KT + (((size_t)g * 2 + 1) * 16 + h) * 1024;
#pragma unroll
            for (int pass = 0; pass < 2; ++pass) { const int ch = lane + 64 * pass, j = ch >> 1, hh = (ch & 1) * 8;
                f32x4 a, b;
                if (j < i) { const float* s = kt0 + (i - j) * 16 + hh; a = *(const f32x4*)s; b = *(const f32x4*)(s + 4); }
                else if (j > i) { const float* s = kt1 + (j - i) * 16 + hh; a = *(const f32x4*)s; b = *(const f32x4*)(s + 4); }
                else { const float* s0 = kt0 + hh; const float* s1 = kt1 + hh; a = *(const f32x4*)s0 + *(const f32x4*)s1; b = *(const f32x4*)(s0 + 4) + *(const f32x4*)(s1 + 4);
                    const float dd = ssm_d[g * GH + h];
#pragma unroll
                    for (int e = 0; e < 4; ++e) { if (hh + e == h) a[e] += dd; if (hh + 4 + e == h) b[e] += dd; } }
                *(u32x4*)(dst + ch * 8) = pack8(a, b); }
            if (lane < 32) { const int kk0 = lane * 8, dir = kk0 >> 7, ri = (kk0 >> 6) & 1, p0 = kk0 & 63; const int e = dir ? 64 - i : i + 1;
                const f32x2* pw = APW + (((size_t)g * 2 + dir) * 65 + e) * 64 + p0; const size_t ci = (((size_t)dir * NG + g) * GH + h) * PS + p0;
                float v[8];
#pragma unroll
                for (int q = 0; q < 8; ++q) { const f32x2 w = pw[q]; const float cr = c_re[ci + q], cim = c_im[ci + q]; v[q] = ri ? -(cr * w.y + cim * w.x) : (cr * w.x - cim * w.y); }
                u32x4 o; o.x = cvt_pk_bf16(v[0], v[1]); o.y = cvt_pk_bf16(v[2], v[3]); o.z = cvt_pk_bf16(v[4], v[5]); o.w = cvt_pk_bf16(v[6], v[7]);
                *(u32x4*)(dst + 1024 + kk0) = o; }
        }
        if (rep == 0) for (int sr_ = 0; sr_ < SUBREPS(6); ++sr_) {
            const Sh2Rows rp{MOD};
            for (int task = NGW - 1 - gw; task < (F2 / 64) * 16; task += NGW) { const int cb = task >> 4, ks = task & 15;
                gemv_task<NB, false>(wscr, rp, w_up, F2, cb * 64, ks * 64, 64, sr_ ? (float*)(ws + WS_E) : BIASUP, F2, nullptr, lane); }
        }
        for (int sr_ = 0; sr_ < SUBREPS(4); ++sr_) {
            const int per = ((M + MC + NGW - 1) / NGW + 3) & ~3; const int rbeg = gw * per, rend = (rbeg + per) < (M + MC) ? (rbeg + per) : (M + MC);
            int cur = -1; f32x4 pa[4], pb[4];
            for (int row0 = rbeg; row0 < rend; row0 += 4) {
                const int mr = row0 < M ? (row0 >> 11) : NB;
                if (mr != cur) { cur = mr; const float* sh = MOD + (size_t)mr * 6 * D; const float* sc = sh + D;
#pragma unroll
                    for (int jq = 0; jq < 4; ++jq) { const int col = 4 * lane + 256 * jq; pa[jq] = *(const f32x4*)(n1g + col) * (*(const f32x4*)(sc + col) + 1.f); pb[jq] = *(const f32x4*)(sh + col); } }
                f32x4 v[4][4]; float ss[4];
#pragma unroll
                for (int u = 0; u < 4; ++u) { const int row = row0 + u; const float* xr = row < M ? x + (size_t)row * D : ctx + (size_t)(row - M) * D;
#pragma unroll
                    for (int jq = 0; jq < 4; ++jq) v[u][jq] = *(const f32x4*)(xr + 4 * lane + 256 * jq); }
#pragma unroll
                for (int u = 0; u < 4; ++u) { ss[u] = 0.f;
#pragma unroll
                    for (int jq = 0; jq < 4; ++jq) ss[u] += (v[u][jq][0] * v[u][jq][0] + v[u][jq][1] * v[u][jq][1]) + (v[u][jq][2] * v[u][jq][2] + v[u][jq][3] * v[u][jq][3]); }
#pragma unroll
                for (int o = 1; o < 64; o <<= 1) {
#pragma unroll
                    for (int u = 0; u < 4; ++u) ss[u] += __shfl_xor(ss[u], o); }
#pragma unroll
                for (int u = 0; u < 4; ++u) { const int row = row0 + u; const float r = rsqrtf(ss[u] * (1.f / D) + EPS);
#pragma unroll
                    for (int jq = 0; jq < 4; ++jq) { const int col = 4 * lane + 256 * jq; const f32x4 o = v[u][jq] * r * pa[jq] + pb[jq];
                        u32x2 w; w.x = cvt_pk_bf16(o[0], o[1]); w.y = cvt_pk_bf16(o[2], o[3]); *(u32x2*)(H + (size_t)row * D + col) = w; } }
            }
        }
    }
    SEAM(PH_NORM1);

    if (IN(PH_GEMM1)) {
        const EpiGemm1 Ep{AG, P};
        { pg8::PlainSched S; S.init(H, D, WIN, D, M, PCOLS, G, bx, 0); S.reps = REPS(PH_GEMM1); pg8::gemm_phase(lds, D, D, D, S, Ep); }
        { pg8::PlainSched S; S.init(H + (size_t)M * D, D, WIN, D, MC, SW, G, bx, 1); pg8::gemm_phase(lds, D, D, D, S, Ep); }
    }
    SEAM(PH_GEMM1);

    if (IN(PH_SSME)) {
        { pg8::BatchSched S; S.init(AG, AGK, (size_t)AGR * AGK * 2, WE, 1024, (size_t)256 * 1024 * 2, 5, 1, NG, G, bx); S.reps = REPS(PH_SSME); pg8::gemm_phase(lds, 1024, AGK, 1024, S, EpiE{E}); }
        {
            const int q = tid & 63, rl = tid >> 6; f32x4 w[3][2];
#pragma unroll
            for (int k = 0; k < 3; ++k) { w[k][0] = *(const f32x4*)(sconv_w + k * SW + q * 8); w[k][1] = *(const f32x4*)(sconv_w + k * SW + q * 8 + 4); }
            volatile LAS int* s_chunk = (volatile LAS int*)(lds + 131072 + 64);
            unsigned* cnt = (unsigned*)(ws + WS_YBRCNT);
            for (;;) {
                __syncthreads();
                if (tid == 0) *s_chunk = (int)__hip_atomic_fetch_add(cnt, 1u, __ATOMIC_RELAXED, __HIP_MEMORY_SCOPE_AGENT);
                __syncthreads();
                const int chunk = *s_chunk; if (chunk >= M / 128) break;
#pragma unroll 1
                for (int it = 0; it < 16; it += 2) {
                    u32x4 cw[2][3], xw[2][3], gwd[2];
#pragma unroll
                    for (int u = 0; u < 2; ++u) { const int m = chunk * 128 + (it + u) * 8 + rl, t = m & 2047;
#pragma unroll
                        for (int k = 0; k < 3; ++k) { const int tt = t + k - 1; const bool okk = tt >= 0 && tt < SEQ; const bf16_t* pr = P + (size_t)(okk ? m + k - 1 : m) * PW + q * 8;
                            cw[u][k] = *(const u32x4*)(pr + 512); xw[u][k] = *(const u32x4*)(pr + 1024); if (!okk) { cw[u][k] = (u32x4){0u, 0u, 0u, 0u}; xw[u][k] = (u32x4){0u, 0u, 0u, 0u}; } }
                        gwd[u] = *(const u32x4*)(P + (size_t)m * PW + q * 8); }
#pragma unroll
                    for (int u = 0; u < 2; ++u) { const int m = chunk * 128 + (it + u) * 8 + rl; f32x4 s0 = {0.f, 0.f, 0.f, 0.f}, s1 = {0.f, 0.f, 0.f, 0.f};
#pragma unroll
                        for (int k = 0; k < 3; ++k) { f32x4 c0, c1, x0, x1; unpack8(cw[u][k], c0, c1); unpack8(xw[u][k], x0, x1); s0 += w[k][0] * (c0 * x0); s1 += w[k][1] * (c1 * x1); }
                        f32x4 g0, g1; unpack8(gwd[u], g0, g1);
                        *(u32x4*)(YBR + (size_t)m * SW + q * 8) = pack8(g0 * s0, g1 * s1); }
                }
            }
        }
    }
    SEAM(PH_SSME);

    if (IN(PH_SCAN)) for (int rep = 0; rep < REPS(PH_SCAN); ++rep) {
        for (int idx = gt; idx < NB * NG * 2 * PS; idx += NGT) {
            const int p = idx & 63, dir = (idx >> 6) & 1, g = (idx >> 7) & 31, b = idx >> 12;
            const f32x2 aT = APW[(((size_t)g * 2 + dir) * 65 + 64) * 64 + p];
            const float* Eg = E + (size_t)g * AGR * 256 + dir * 128 + p;
            bf16_t* Sg = AG + (size_t)g * AGR * AGK + 1024 + dir * 128 + p;
            float er[NCC + NCL], ei[NCC + NCL];
#pragma unroll
            for (int cc = 0; cc < NCC; ++cc) { const int c = dir ? NCC - 1 - cc : cc; const int row = NB * NCL + b * NCC + c; er[cc] = Eg[(size_t)row * 256]; ei[cc] = Eg[(size_t)row * 256 + 64]; }
#pragma unroll
            for (int cc = 0; cc < NCL; ++cc) { const int c = dir ? NCL - 1 - cc : cc; const int row = b * NCL + c; er[NCC + cc] = Eg[(size_t)row * 256]; ei[NCC + cc] = Eg[(size_t)row * 256 + 64]; }
            float sr = 0.f, si = 0.f;
#pragma unroll
            for (int cc = 0; cc < NCC; ++cc) { const float nr = aT.x * sr - aT.y * si + er[cc], ni = aT.x * si + aT.y * sr + ei[cc]; sr = nr; si = ni; }
#pragma unroll
            for (int cc = 0; cc < NCL; ++cc) { const int c = dir ? NCL - 1 - cc : cc; const int row = b * NCL + c;
                Sg[(size_t)row * AGK] = f2bf(sr); Sg[(size_t)row * AGK + 64] = f2bf(si);
                const float nr = aT.x * sr - aT.y * si + er[NCC + cc], ni = aT.x * si + aT.y * sr + ei[NCC + cc]; sr = nr; si = ni; }
        }
    }
    SEAM(PH_SCAN);

    if (IN(PH_SSMY)) {
        pg8::BatchSched S; S.init(AG, AGK, (size_t)AGR * AGK * 2, OP, AGK, (size_t)1024 * AGK * 2, 4, 4, NG, G, bx); S.reps = REPS(PH_SSMY); pg8::gemm_phase(lds, AGK, AGK, AGK, S, EpiY{Z});
    }
    SEAM(PH_SSMY);

    if (IN(PH_GLU)) { pg8::PlainSched S; S.init(Z, SW, WGLU, SW, M, SW, G, bx, 0); S.reps = REPS(PH_GLU); pg8::gemm_phase(lds, SW, SW, SW, S, EpiGlu{Z, glu_b, YA}); }
    SEAM(PH_GLU);

    if (IN(PH_PROJ)) {
        { pg8::PlainSched S; S.init(YA, SW, WPA, SW, M, D, G, bx, 0); S.reps = REPS(PH_PROJ); pg8::gemm_phase(lds, SW, SW, SW, S, EpiProj<false>{P, MG}); }
        { pg8::PlainSched S; S.init(YBR, SW, WPB, SW, M, D, G, bx, 0); pg8::gemm_phase(lds, SW, SW, SW, S, EpiProj<true>{P, MG}); }
    }
    SEAM(PH_PROJ);

    if (IN(PH_OUT)) { pg8::PlainSched S; S.init(MG, D, WOUT, D, M, D, G, bx, 0); S.reps = REPS(PH_OUT); pg8::gemm_phase(lds, D, D, D, S, EpiOut{x, MOD, n2g, out, X1S, SS1}); }
    SEAM(PH_OUT);

    if (IN(PH_UP0)) { pg8::PlainSched S; S.init(X1S, D, WUP, D, HALF_ROWS, F2, G, bx, 0); S.reps = REPS(PH_UP0); pg8::gemm_phase(lds, D, D, D, S, EpiUp{SS1, BIASUP, UP, 0}); }
    SEAM(PH_UP0);
    if (IN(PH_CONV0)) for (int rep = 0; rep < REPS(PH_CONV0); ++rep) conv_phase(lds + wave * 16384, UP, conv_w, ACT, ws + WS_ZEROS, vgw, NGW, lane);
    SEAM(PH_CONV0);
    if (IN(PH_DOWN0UP1)) {
        { pg8::PlainSched S; S.init(ACT, FH, WDOWN, FH, HALF_ROWS, D, G, bx, 0); pg8::gemm_phase(lds, FH, FH, FH, S, EpiDown{MOD, out, SS2, 0}); }
        { pg8::PlainSched S; S.init(X1S + (size_t)HALF_ROWS * D, D, WUP, D, HALF_ROWS, F2, G, bx, 0); pg8::gemm_phase(lds, D, D, D, S, EpiUp{SS1, BIASUP, UP, HALF_ROWS}); }
    }
    SEAM(PH_DOWN0UP1);
    if (IN(PH_CONV1)) for (int rep = 0; rep < REPS(PH_CONV1); ++rep) conv_phase(lds + wave * 16384, UP, conv_w, ACT, ws + WS_ZEROS, vgw, NGW, lane);
    SEAM(PH_CONV1);
    if (IN(PH_DOWN1)) { pg8::PlainSched S; S.init(ACT, FH, WDOWN, FH, HALF_ROWS, D, G, bx, 0); pg8::gemm_phase(lds, FH, FH, FH, S, EpiDown{MOD, out, SS2, HALF_ROWS}); }
    SEAM(PH_DOWN1);

    if (IN(PH_FINAL)) {
        const int cq = gt & 255; const f32x4 fg = *(const f32x4*)(final_g + cq * 4); const int rstride = NGT >> 8;
        for (int row = gt >> 8; row < M; row += 8 * rstride) {
            f32x4 v[8]; float rs[8];
#pragma unroll
            for (int u = 0; u < 8; ++u) { const int rr = row + u * rstride; if (rr < M) { v[u] = *(const f32x4*)(out + (size_t)rr * D + cq * 4); rs[u] = SS2[rr]; } }
#pragma unroll
            for (int u = 0; u < 8; ++u) { const int rr = row + u * rstride; if (rr < M) *(f32x4*)(out + (size_t)rr * D + cq * 4) = v[u] * rsqrtf(rs[u] * (1.f / D) + EPS) * fg; }
        }
    }
}

extern "C" void kernel_launch(void* const* d_in, const int* in_sizes, int n_in, void* d_out, int out_size, void* d_ws, size_t ws_size, hipStream_t stream) {
    static int grid = 0;
    if (grid == 0) {
        if (n_in != 27 || ws_size < WS_NEED || out_size != M * D) { fprintf(stderr, "kernel_launch: bad args n_in=%d ws=%zu out=%d\n", n_in, ws_size, out_size); grid = -1; return; }
        int dev = 0, cus = 0, per_cu = 0;
        if (hipGetDevice(&dev) != hipSuccess || hipDeviceGetAttribute(&cus, hipDeviceAttributeMultiprocessorCount, dev) != hipSuccess) { grid = -1; return; }
        if (hipFuncSetAttribute((const void*)mega, hipFuncAttributeMaxDynamicSharedMemorySize, LDS_BYTES) != hipSuccess) { fprintf(stderr, "kernel_launch: hipFuncSetAttribute failed\n"); grid = -1; return; }
        if (hipOccupancyMaxActiveBlocksPerMultiprocessor(&per_cu, (const void*)mega, NTHREADS, LDS_BYTES) != hipSuccess || per_cu < 1) { fprintf(stderr, "kernel_launch: occupancy query says %d\n", per_cu); (void)hipGetLastError(); grid = -1; return; }
        grid = cus;
        if (grid % 8 != 0) { fprintf(stderr, "kernel_launch: CU count %d not a multiple of 8\n", grid); grid = -1; return; }
    }
    if (grid < 0) return;
    const float* x = (const float*)d_in[0]; const float* c = (const float*)d_in[1]; const float* ctx = (const float*)d_in[2]; const float* c_ctx = (const float*)d_in[3];
    const float* mod_w = (const float*)d_in[4]; const float* mod_b = (const float*)d_in[5]; const float* n1g = (const float*)d_in[6]; const float* n2g = (const float*)d_in[7];
    const float* w_in = (const float*)d_in[8]; const float* lam_re = (const float*)d_in[9]; const float* lam_im = (const float*)d_in[10]; const float* log_dt = (const float*)d_in[11];
    const float* b_re = (const float*)d_in[12]; const float* b_im = (const float*)d_in[13]; const float* c_re = (const float*)d_in[14]; const float* c_im = (const float*)d_in[15];
    const float* ssm_d = (const float*)d_in[16]; const float* glu_w = (const float*)d_in[17]; const float* glu_b = (const float*)d_in[18]; const float* sconv_w = (const float*)d_in[19];
    const float* proj_a = (const float*)d_in[20]; const float* proj_b = (const float*)d_in[21]; const float* w_out = (const float*)d_in[22]; const float* w_up = (const float*)d_in[23];
    const float* conv_w = (const float*)d_in[24]; const float* w_down = (const float*)d_in[25]; const float* final_g = (const float*)d_in[26];
    unsigned char* ws = (unsigned char*)d_ws; float* out = (float*)d_out;
    float* MOD = (float*)(ws + WS_MOD); float* BIASUP = (float*)(ws + WS_BIASUP); float* SS1 = (float*)(ws + WS_SS1); float* SS2 = (float*)(ws + WS_SS2);
    bf16_t* P = (bf16_t*)(ws + WS_P); bf16_t* H = (bf16_t*)(ws + WS_H); bf16_t* AG = (bf16_t*)(ws + WS_AG);
    bf16_t* YBR = (bf16_t*)(ws + WS_YBR); bf16_t* Z = (bf16_t*)(ws + WS_Z); bf16_t* YA = (bf16_t*)(ws + WS_YA); bf16_t* MG = (bf16_t*)(ws + WS_MERGED);
    bf16_t* X1S = (bf16_t*)(ws + WS_X1S); bf16_t* UP = (bf16_t*)(ws + WS_UP); bf16_t* ACT = (bf16_t*)(ws + WS_ACT);
    float* YF = (float*)(ws + WS_H);

    (void)hipMemsetAsync(ws + WS_CTL, 0, CTL_ZERO_BYTES, stream);
    Args a{};
    for (int i = 0; i < 27; ++i) a.in[i] = (const float*)d_in[i];
    a.out = out; a.ws = ws;
#define RUN(lo_, hi_) do { a.ph_lo = (lo_); a.ph_hi = (hi_); hipLaunchKernelGGL(mega, dim3(grid), dim3(NTHREADS), LDS_BYTES, stream, a); } while (0)
#define OPT(p) ((OPT_MASK >> (p)) & 1)
#if MK_ONE_LAUNCH
    a.ph_lo = 0; a.ph_hi = PH_COUNT;
    void* kargs[] = {&a};
    hipError_t e = hipLaunchCooperativeKernel((const void*)mega, dim3(grid), dim3(NTHREADS), kargs, LDS_BYTES, stream);
    if (e != hipSuccess) fprintf(stderr, "kernel_launch: cooperative launch failed: %s\n", hipGetErrorString(e));
#else
    if (OPT(0)) RUN(PH_PRO, PH_PRO + 1); else k_mod<<<dim3(6 * D / 256, NB + 1), 256, 0, stream>>>(c, c_ctx, mod_w, mod_b, MOD);
    if (OPT(1)) RUN(PH_NORM1, PH_NORM1 + 1);
    else { k_norm1<<<(M + MC) / 4, 256, 0, stream>>>(x, ctx, n1g, MOD, H); k_biasup<<<dim3(F2 / 256, NB), 256, 0, stream>>>(MOD, w_up, BIASUP); }
    if (OPT(2)) RUN(PH_GEMM1, PH_GEMM1 + 1);
    else { k_gemm<EpiIn><<<dim3(PCOLS / 64, M / 64), 256, 0, stream>>>(H, D, w_in, PCOLS, D, EpiIn{AG, P});
           k_gemm<EpiInCtx><<<dim3(SW / 64, MC / 64), 256, 0, stream>>>(H + (size_t)M * D, D, w_in, PCOLS, D, EpiInCtx{AG}); }
    if (OPT(3)) { RUN(PH_SSME, PH_SSME + 1); RUN(PH_SCAN, PH_SCAN + 1); RUN(PH_SSMY, PH_SSMY + 1); }
    else { k_ybr<<<(unsigned)(((size_t)M * SW + 255) / 256), 256, 0, stream>>>(P, sconv_w, YBR);
           k_ssm<<<dim3(NB, NG), 64, 0, stream>>>(AG, lam_re, lam_im, log_dt, b_re, b_im, c_re, c_im, ssm_d, YF, Z); }
    if (OPT(4)) RUN(PH_GLU, PH_GLU + 1); else k_gemm<EpiGluN><<<dim3(SW / 64, M / 64), 256, 0, stream>>>(Z, SW, glu_w, SW, SW, EpiGluN{Z, glu_b, YA});
    if (OPT(5)) RUN(PH_PROJ, PH_PROJ + 1);
    else { k_gemm<EpiProjAN><<<dim3(D / 64, M / 64), 256, 0, stream>>>(YA, SW, proj_a, D, SW, EpiProjAN{P, MG});
           k_gemm<EpiProjBN><<<dim3(D / 64, M / 64), 256, 0, stream>>>(YBR, SW, proj_b, D, SW, EpiProjBN{P, MG}); }
    if (OPT(6)) RUN(PH_OUT, PH_OUT + 1);
    else { k_gemm<EpiOutN><<<dim3(D / 64, M / 64), 256, 0, stream>>>(MG, D, w_out, D, D, EpiOutN{x, MOD, n2g, out, X1S}); k_rowss<<<M / 4, 256, 0, stream>>>(out, SS1); }
    if (OPT(7)) { RUN(PH_UP0, PH_UP0 + 1); RUN(PH_CONV0, PH_CONV0 + 1); RUN(PH_DOWN0UP1, PH_DOWN0UP1 + 1); RUN(PH_CONV1, PH_CONV1 + 1); RUN(PH_DOWN1, PH_DOWN1 + 1); RUN(PH_FINAL, PH_FINAL + 1); }
    else {
        for (int half = 0; half < 2; ++half) { const int row0 = half * HALF_ROWS;
            k_gemm<EpiUpN><<<dim3(F2 / 64, HALF_ROWS / 64), 256, 0, stream>>>(X1S + (size_t)row0 * D, D, w_up, F2, D, EpiUpN{SS1, BIASUP, UP, row0, 0});
            k_conv<<<(unsigned)(((size_t)HALF_ROWS * FH + 255) / 256), 256, 0, stream>>>(UP, conv_w, ACT);
            k_gemm<EpiDownN><<<dim3(D / 64, HALF_ROWS / 64), 256, 0, stream>>>(ACT, FH, w_down, D, FH, EpiDownN{MOD, out, row0, 0}); }
        k_final<<<M / 4, 256, 0, stream>>>(out, final_g);
    }
#endif
}
```
